# Optimizing an MI355X kernel written in HIP

```python
import jax, jax.numpy as jnp
from jax import lax
import numpy as np

D_MODEL = 1024
BATCH = 8
SEQ = 2048
DEPTH = 2

HEAD_DIM = 64
SWA_Q_HEADS = 8
SWA_KV_HEADS = 2
SWA_WINDOW = 128
SB_HEADS = 8
SB_Q_BLOCK = 128
MOBA_HEADS = 8
MOBA_BLOCK = 256
MOBA_TOPK = 3
MOBA_Q_CHUNK = 16
BRANCH_WIDTH = 512
N_BRANCHES = 3
D_FF = 2816
CONV_WIDTH = 3
ROPE_THETA = 10000.0
RMS_EPS = 1e-6

IN_SIZES = (
    SWA_Q_HEADS * HEAD_DIM, SWA_KV_HEADS * HEAD_DIM, SWA_KV_HEADS * HEAD_DIM,
    SB_HEADS * HEAD_DIM, SB_HEADS * HEAD_DIM, SB_HEADS * HEAD_DIM,
    MOBA_HEADS * HEAD_DIM, MOBA_HEADS * HEAD_DIM, MOBA_HEADS * HEAD_DIM,
    N_BRANCHES * D_MODEL,
)
D_IN = sum(IN_SIZES)

kernel_name = "hybrid_gated_swa_stickbreak_moba_block"


def rmsnorm(x, g):
    xf = x.astype(jnp.float32)
    y = xf * lax.rsqrt(jnp.mean(xf * xf, axis=-1, keepdims=True) + RMS_EPS)
    return (y * g.astype(jnp.float32)).astype(x.dtype)


def rope_tables(seq):
    inv = ROPE_THETA ** (-jnp.arange(0, HEAD_DIM, 2, dtype=jnp.float32) / HEAD_DIM)
    ang = jnp.arange(seq, dtype=jnp.float32)[:, None] * inv[None, :]
    return jnp.cos(ang), jnp.sin(ang)


def apply_rope(x, cos, sin):
    x1, x2 = jnp.split(x.astype(jnp.float32), 2, axis=-1)
    c = cos[None, :, None, :]
    s = sin[None, :, None, :]
    return jnp.concatenate([x1 * c - x2 * s, x2 * c + x1 * s], axis=-1).astype(x.dtype)


def swa_sink_attention(q, k, v, sinks):
    B, S = q.shape[0], q.shape[1]
    W = SWA_WINDOW
    nblk = S // W
    G = SWA_Q_HEADS // SWA_KV_HEADS
    scale = HEAD_DIM ** -0.5
    qb = q.reshape(B, nblk, W, SWA_KV_HEADS, G, HEAD_DIM)
    kb = k.reshape(B, nblk, W, SWA_KV_HEADS, HEAD_DIM)
    vb = v.reshape(B, nblk, W, SWA_KV_HEADS, HEAD_DIM)
    pad = ((0, 0), (1, 0), (0, 0), (0, 0), (0, 0))
    kk = jnp.concatenate([jnp.pad(kb, pad)[:, :-1], kb], axis=2)
    vv = jnp.concatenate([jnp.pad(vb, pad)[:, :-1], vb], axis=2)
    scores = jnp.einsum('bnqhgd,bnkhd->bnhgqk', qb, kk).astype(jnp.float32) * scale
    qpos = jnp.arange(W)[:, None] + W
    kpos = jnp.arange(2 * W)[None, :]
    diff = qpos - kpos
    band = (diff >= 0) & (diff < W)
    blk = jnp.arange(nblk)[:, None, None]
    valid = band[None] & ((blk * W + kpos[None] - W) >= 0)
    scores = jnp.where(valid[None, :, None, None], scores, -jnp.inf)
    sink = sinks.astype(jnp.float32).reshape(SWA_KV_HEADS, G)[None, None, :, :, None, None]
    sink = jnp.broadcast_to(sink, scores.shape[:-1] + (1,))
    probs = jax.nn.softmax(jnp.concatenate([scores, sink], axis=-1), axis=-1)[..., :-1]
    out = jnp.einsum('bnhgqk,bnkhd->bnqhgd', probs.astype(v.dtype), vv)
    return out.reshape(B, S, SWA_Q_HEADS * HEAD_DIM)


def stick_breaking_attention(q, k, v):
    B, S, H, dh = q.shape
    nblk = S // SB_Q_BLOCK
    scale = dh ** -0.5
    q_blocks = q.reshape(B, nblk, SB_Q_BLOCK, H, dh).transpose(1, 0, 2, 3, 4)
    kpos = jnp.arange(S)

    def block(args):
        q_blk, i = args
        z = jnp.einsum('bqhd,bkhd->bhqk', q_blk, k).astype(jnp.float32) * scale
        qpos = i * SB_Q_BLOCK + jnp.arange(SB_Q_BLOCK)
        past = kpos[None, :] < qpos[:, None]
        log_beta = jax.nn.log_sigmoid(z)
        log_one_minus = jnp.where(past, jax.nn.log_sigmoid(-z), 0.0)
        remain = lax.cumsum(log_one_minus, axis=3, reverse=True) - log_one_minus
        w = jnp.where(past, jnp.exp(log_beta + remain), 0.0)
        return jnp.einsum('bhqk,bkhd->bqhd', w.astype(v.dtype), v)

    out = lax.map(block, (q_blocks, jnp.arange(nblk)))
    return out.transpose(1, 0, 2, 3, 4).reshape(B, S, H * dh)


def moba_attention(q, k, v):
    B, S, H, dh = q.shape
    nb = -(-S // MOBA_BLOCK)
    pad = nb * MOBA_BLOCK - S
    ksel = min(MOBA_TOPK, nb)
    scale = dh ** -0.5
    kp = jnp.pad(k, ((0, 0), (0, pad), (0, 0), (0, 0)))
    vp = jnp.pad(v, ((0, 0), (0, pad), (0, 0), (0, 0)))
    kb = kp.reshape(B, nb, MOBA_BLOCK, H, dh)
    vb = vp.reshape(B, nb, MOBA_BLOCK, H, dh)
    k_mean = jnp.mean(kb.astype(jnp.float32), axis=2)
    gate = jnp.einsum('bshd,bnhd->bhsn', q.astype(jnp.float32), k_mean)
    q_blk = jnp.arange(S) // MOBA_BLOCK
    past_blk = jnp.arange(nb)[None, :] < q_blk[:, None]
    gate = jnp.where(past_blk[None, None], gate, -jnp.inf)
    _, sel = lax.top_k(gate, ksel)
    sel_valid = sel < q_blk[None, None, :, None]

    C = MOBA_Q_CHUNK
    nchunk = S // C
    q_c = q.reshape(B, nchunk, C, H, dh).transpose(1, 0, 2, 3, 4)
    sel_c = sel.reshape(B, H, nchunk, C, ksel).transpose(2, 0, 1, 3, 4)
    valid_c = sel_valid.reshape(B, H, nchunk, C, ksel).transpose(2, 0, 1, 3, 4)
    kb_h = kb.transpose(0, 3, 1, 2, 4)
    vb_h = vb.transpose(0, 3, 1, 2, 4)
    gather = jax.vmap(jax.vmap(lambda blocks, idx: blocks[idx]))

    def chunk(args):
        q_blk, sel_blk, valid_blk, i = args
        t0 = i * C
        qpos = t0 + jnp.arange(C)
        own_start = (t0 // MOBA_BLOCK) * MOBA_BLOCK
        k_own = lax.dynamic_slice_in_dim(kp, own_start, MOBA_BLOCK, axis=1)
        v_own = lax.dynamic_slice_in_dim(vp, own_start, MOBA_BLOCK, axis=1)
        k_sel = gather(kb_h, sel_blk)
        v_sel = gather(vb_h, sel_blk)
        s_sel = jnp.einsum('bqhd,bhqnkd->bhqnk', q_blk, k_sel).astype(jnp.float32) * scale
        s_sel = jnp.where(valid_blk[..., None], s_sel, -jnp.inf).reshape(B, H, C, ksel * MOBA_BLOCK)
        s_own = jnp.einsum('bqhd,bkhd->bhqk', q_blk, k_own).astype(jnp.float32) * scale
        kpos_own = own_start + jnp.arange(MOBA_BLOCK)
        s_own = jnp.where(kpos_own[None, :] <= qpos[:, None], s_own, -jnp.inf)
        p = jax.nn.softmax(jnp.concatenate([s_sel, s_own], axis=-1), axis=-1)
        p_sel = p[..., :ksel * MOBA_BLOCK].reshape(B, H, C, ksel, MOBA_BLOCK).astype(v.dtype)
        p_own = p[..., ksel * MOBA_BLOCK:].astype(v.dtype)
        return (jnp.einsum('bhqnk,bhqnkd->bqhd', p_sel, v_sel)
                + jnp.einsum('bhqk,bkhd->bqhd', p_own, v_own))

    out = lax.map(chunk, (q_c, sel_c, valid_c, jnp.arange(nchunk)))
    return out.transpose(1, 0, 2, 3, 4).reshape(B, S, H * dh)


def causal_depthwise_conv(u, w, b):
    S = u.shape[1]
    up = jnp.pad(u, ((0, 0), (CONV_WIDTH - 1, 0), (0, 0)))
    out = b
    for tap in range(CONV_WIDTH):
        out = out + w[tap] * up[:, tap:tap + S]
    return out


def hybrid_layer(x, cos, sin, norm_mix, w_in, b_gate, sinks, w_branch, w_out,
                 norm_ffn, w_up, conv_w, conv_b, w_down):
    B, S, _ = x.shape
    h = rmsnorm(x, norm_mix)
    proj = h @ w_in
    points = np.cumsum(IN_SIZES)[:-1].tolist()
    qa, ka, va, qb, kb, vb, qc, kc, vc, gates = jnp.split(proj, points, axis=-1)
    heads = lambda t, n: t.reshape(B, S, n, HEAD_DIM)
    o_a = swa_sink_attention(apply_rope(heads(qa, SWA_Q_HEADS), cos, sin),
                             apply_rope(heads(ka, SWA_KV_HEADS), cos, sin),
                             heads(va, SWA_KV_HEADS), sinks)
    o_b = stick_breaking_attention(heads(qb, SB_HEADS), heads(kb, SB_HEADS), heads(vb, SB_HEADS))
    o_c = moba_attention(apply_rope(heads(qc, MOBA_HEADS), cos, sin),
                         apply_rope(heads(kc, MOBA_HEADS), cos, sin),
                         heads(vc, MOBA_HEADS))
    g = jax.nn.sigmoid(gates.reshape(B, S, N_BRANCHES, D_MODEL) + b_gate.reshape(N_BRANCHES, D_MODEL))
    merged = (g[:, :, 0] * (o_a @ w_branch[0])
              + g[:, :, 1] * (o_b @ w_branch[1])
              + g[:, :, 2] * (o_c @ w_branch[2]))
    x = x + merged @ w_out
    h = rmsnorm(x, norm_ffn)
    u = causal_depthwise_conv(h @ w_up, conv_w, conv_b)
    u_a, u_v = jnp.split(u, 2, axis=-1)
    return x + (jax.nn.silu(u_a) * u_v) @ w_down


def setup_inputs(seed: int = 0) -> dict:
    key = jax.random.key(seed)
    ks = jax.random.split(key, 13)
    f32 = jnp.float32
    nrm = lambda k, shape, s: jax.random.normal(k, shape, f32) * s
    return {
        "x": nrm(ks[0], (BATCH, SEQ, D_MODEL), 1.0),
        "norm_mix": 1.0 + nrm(ks[1], (DEPTH, D_MODEL), 0.02),
        "w_in": nrm(ks[2], (DEPTH, D_MODEL, D_IN), D_MODEL ** -0.5),
        "b_gate": nrm(ks[3], (DEPTH, N_BRANCHES * D_MODEL), 0.1),
        "sinks": nrm(ks[4], (DEPTH, SWA_Q_HEADS), 0.5),
        "w_branch": nrm(ks[5], (DEPTH, N_BRANCHES, BRANCH_WIDTH, D_MODEL), BRANCH_WIDTH ** -0.5),
        "w_out": nrm(ks[6], (DEPTH, D_MODEL, D_MODEL), D_MODEL ** -0.5),
        "norm_ffn": 1.0 + nrm(ks[7], (DEPTH, D_MODEL), 0.02),
        "w_up": nrm(ks[8], (DEPTH, D_MODEL, 2 * D_FF), D_MODEL ** -0.5),
        "conv_w": nrm(ks[9], (DEPTH, CONV_WIDTH, 2 * D_FF), CONV_WIDTH ** -0.5),
        "conv_b": nrm(ks[10], (DEPTH, 2 * D_FF), 0.01),
        "w_down": nrm(ks[11], (DEPTH, D_FF, D_MODEL), D_FF ** -0.5),
        "norm_final": 1.0 + nrm(ks[12], (D_MODEL,), 0.02),
    }


def reference(x, norm_mix, w_in, b_gate, sinks, w_branch, w_out, norm_ffn,
              w_up, conv_w, conv_b, w_down, norm_final):
    cos, sin = rope_tables(x.shape[1])
    for layer in range(DEPTH):
        x = hybrid_layer(x, cos, sin, norm_mix[layer], w_in[layer], b_gate[layer],
                         sinks[layer], w_branch[layer], w_out[layer], norm_ffn[layer],
                         w_up[layer], conv_w[layer], conv_b[layer], w_down[layer])
    return rmsnorm(x, norm_final)
```

```cpp
#include <hip/hip_runtime.h>
#include <hip/hip_cooperative_groups.h>
#include <cstdio>
#include <cstdint>
namespace cg = cooperative_groups;
namespace pg8 {
#define PG8_LAS __attribute__((address_space(3)))
typedef unsigned short bf16_t;
typedef short bf16x8 __attribute__((ext_vector_type(8)));
typedef float f32x4 __attribute__((ext_vector_type(4)));
typedef unsigned u32x4 __attribute__((ext_vector_type(4)));
constexpr int BM = 256, BK = 64, HALF = 128, HTB = HALF * BK * 2  , STAGE_BYTES = 8 * HTB, NXCD = 8, WGM = 8;

__host__ __device__ __forceinline__ int lds_byte(int r, int c) { const int st = (r >> 4) * 2 + (c >> 5), rr = r & 15, cc = c & 31, ob = rr * 64 + cc * 2; return st * 1024 + (ob ^ (((ob >> 9) & 1) << 5)); }
__host__ __device__ __forceinline__ void stage_rc(int b, int& R, int& C) { const int st = b / 1024, sb = b % 1024, swz = sb ^ (((sb >> 9) & 1) << 5); R = (st >> 1) * 16 + swz / 64; C = (st & 1) * 32 + (swz % 64) / 2; }
__host__ __device__ __forceinline__ int perm32(int rho) { const int n = rho >> 4, i = rho & 15; return 8 * (i >> 2) + 4 * n + (i & 3); }

struct Unit { int pm, pn; };
struct Gemm { const bf16_t* A; const bf16_t* Bt; int M, N, K, lda; };

struct StaticOrder {
    int nM, nN, nwg, G, c;
    __host__ __device__ void init(int M, int N, int G_, int c_) { nM = M / BM; nN = N / BM; nwg = nM * nN; G = G_; c = c_; }
    __host__ __device__ bool next(int i, Unit& u) const {
        const long L = (long)i * G + c; if (L >= nwg) return false;
        int wgid = (int)L; { const int q = nwg / NXCD, r = nwg % NXCD, xcd = wgid % NXCD, off = wgid / NXCD; wgid = (xcd < r ? xcd * (q + 1) : r * (q + 1) + (xcd - r) * q) + off; }
        const int nig = WGM * nN, gid = wgid / nig, fm = gid * WGM, gsz = (nM - fm) < WGM ? (nM - fm) : WGM;
        u.pm = fm + ((wgid % nig) % gsz); u.pn = (wgid % nig) / gsz; return true;
    }
    __device__ __forceinline__ void a_ready(const Unit&) const {}
    __device__ __forceinline__ void done(const Unit&) const {}
};

__device__ __forceinline__ unsigned cvt_pk_bf16(float lo, float hi) { unsigned r; asm volatile("v_cvt_pk_bf16_f32 %0, %1, %2" : "=v"(r) : "v"(lo), "v"(hi)); return r; }
typedef float f32x2 __attribute__((ext_vector_type(2)));
template <class Epi, class Sched, bool ALIGN_EPI = false, bool SP2 = false>
__device__ __forceinline__ void gemm_phase(PG8_LAS unsigned char* lds, const Gemm g, const Sched& S, const Epi& E) {
    int tid_ = threadIdx.x; asm volatile("" : "+v"(tid_));
    const int tid = tid_, wid = __builtin_amdgcn_readfirstlane(tid >> 6), lane = tid & 63, wr = wid >> 2, wc = wid & 3, fr = lane & 15, fq = lane >> 4;
    const int K = g.K, nt = K / BK;
    unsigned voffA[2], voffB[2];
#pragma unroll
    for (int i = 0; i < 2; ++i) { int R, C; stage_rc(tid * 16 + i * 8192, R, C); const int Rb = Epi::PERM ? ((R & ~31) + perm32(R & 31)) : R;
        voffA[i] = (unsigned)(R * g.lda + C) * 2u; voffB[i] = (unsigned)(Rb * K + C) * 2u; }
    const size_t kstep = (size_t)(BK * 2);
    const size_t hstep = (size_t)HALF * K * 2;
    const size_t tstep = 2 * hstep; const size_t hstepA = (size_t)HALF * g.lda * 2, tstepA = 2 * hstepA;
    const unsigned ldsw = (unsigned)wid * 1024u;
    const int aoff = lds_byte(wr * 64 + fr, fq * 8), boff = lds_byte(wc * 32 + fr, fq * 8);
#define PG8_SA(b, h) (((b) * 2 + (h)) * HTB)
#define PG8_SB(b, h) ((4 + (b) * 2 + (h)) * HTB)
#define PG8_STAGE(bufoff, gbase, voff) do { _Pragma("unroll") for (int _i = 0; _i < 2; ++_i) \
        __builtin_amdgcn_global_load_lds((const unsigned*)((const char*)(gbase) + (voff)[_i]), (PG8_LAS unsigned*)(lds + (bufoff) + ldsw + _i * 8192), 16, 0, 0); } while (0)
#define PG8_LDA(dst, b, h) do { _Pragma("unroll") for (int m = 0; m < 4; ++m) _Pragma("unroll") for (int k = 0; k < 2; ++k) dst[m][k] = *(const PG8_LAS bf16x8*)(lds + PG8_SA(b, h) + aoff + m * 2048 + k * 1024); } while (0)
#define PG8_LDB(dst, b, h) do { _Pragma("unroll") for (int n = 0; n < 2; ++n) _Pragma("unroll") for (int k = 0; k < 2; ++k) dst[n][k] = *(const PG8_LAS bf16x8*)(lds + PG8_SB(b, h) + boff + n * 2048 + k * 1024); } while (0)
#define PG8_MMA(ai, bj, At, Bt) do { __builtin_amdgcn_s_setprio(1); _Pragma("unroll") for (int m = 0; m < 4; ++m) _Pragma("unroll") for (int n = 0; n < 2; ++n) _Pragma("unroll") for (int k = 0; k < 2; ++k) \
        acc[ai][bj][m][n] = __builtin_amdgcn_mfma_f32_16x16x32_bf16(Bt[n][k], At[m][k], acc[ai][bj][m][n], 0, 0, 0); __builtin_amdgcn_s_setprio(0); } while (0)
#define PG8_WAIT_V(n) asm volatile("s_waitcnt vmcnt(" #n ")" ::: "memory")
#define PG8_WAIT_L(n) asm volatile("s_waitcnt lgkmcnt(" #n ")" ::: "memory")
#define PG8_BAR __builtin_amdgcn_s_barrier()
#define PG8_SCHED __builtin_amdgcn_sched_barrier(0)
    Unit cur, nxt; int ui = 0;
    if (!S.next(0, cur)) return;
    f32x4 acc[2][2][4][2];
#pragma unroll
    for (int a = 0; a < 2; ++a)
#pragma unroll
        for (int b = 0; b < 2; ++b)
#pragma unroll
            for (int m = 0; m < 4; ++m)
#pragma unroll
                for (int n = 0; n < 2; ++n) acc[a][b][m][n] = (f32x4){0.f, 0.f, 0.f, 0.f};
    bf16x8 At[4][2], B0[2][2], B1[2][2];
    const char* cA = (const char*)g.A + (size_t)cur.pm * tstepA; const char* cB = (const char*)g.Bt + (size_t)cur.pn * tstep;
    S.a_ready(cur);
    if constexpr (SP2) {
        PG8_STAGE(PG8_SB(0, 0), cB, voffB); PG8_STAGE(PG8_SB(0, 1), cB + hstep, voffB); PG8_STAGE(PG8_SA(0, 0), cA, voffA); PG8_STAGE(PG8_SA(0, 1), cA + hstepA, voffA);
        if (wr == 1) PG8_BAR;
        PG8_WAIT_V(2); PG8_BAR;
        PG8_STAGE(PG8_SB(1, 0), cB + kstep, voffB); PG8_STAGE(PG8_SA(1, 0), cA + kstep, voffA); PG8_STAGE(PG8_SB(1, 1), cB + hstep + kstep, voffB);
        PG8_WAIT_V(6); PG8_BAR;
    } else {
        PG8_STAGE(PG8_SB(0, 0), cB, voffB); PG8_STAGE(PG8_SA(0, 0), cA, voffA); PG8_STAGE(PG8_SB(0, 1), cB + hstep, voffB); PG8_STAGE(PG8_SA(0, 1), cA + hstepA, voffA);
        if (wr == 1) PG8_BAR;
        PG8_WAIT_V(4); PG8_BAR;
        PG8_STAGE(PG8_SB(1, 0), cB + kstep, voffB); PG8_STAGE(PG8_SA(1, 0), cA + kstep, voffA); PG8_STAGE(PG8_SB(1, 1), cB + hstep + kstep, voffB);
        PG8_WAIT_V(6); PG8_BAR;
    }
    for (;;) {
        const bool has_next = S.next(ui + 1, nxt);
        const char* nA = has_next ? (const char*)g.A + (size_t)nxt.pm * tstepA : cA; const char* nB = has_next ? (const char*)g.Bt + (size_t)nxt.pn * tstep : cB;
        for (int t = 0; t < nt; t += 2) {
            const bool last = (t == nt - 2);
            const char* a1 = cA + (size_t)(t + 1) * kstep;
            const char* a2 = last ? nA : cA + (size_t)(t + 2) * kstep; const char* b2 = last ? nB : cB + (size_t)(t + 2) * kstep;
            const char* a3 = a2 + kstep; const char* b3 = b2 + kstep;
            if (last && has_next) S.a_ready(nxt);
            if constexpr (SP2) {
            PG8_LDB(B0, 0, 0); PG8_LDB(B1, 0, 1); PG8_SCHED; PG8_LDA(At, 0, 0); PG8_STAGE(PG8_SA(1, 1), a1 + hstepA, voffA);
            PG8_WAIT_V(8); PG8_WAIT_L(0); PG8_BAR; PG8_MMA(0, 0, At, B0); PG8_MMA(0, 1, At, B1); PG8_BAR; PG8_SCHED;
            PG8_LDA(At, 0, 1); PG8_STAGE(PG8_SB(0, 0), b2, voffB); PG8_STAGE(PG8_SB(0, 1), b2 + hstep, voffB); PG8_STAGE(PG8_SA(0, 0), a2, voffA);
            PG8_WAIT_V(8); PG8_WAIT_L(0); PG8_BAR; PG8_MMA(1, 0, At, B0); PG8_MMA(1, 1, At, B1); PG8_BAR; PG8_SCHED;
            PG8_LDB(B0, 1, 0); PG8_LDB(B1, 1, 1); PG8_SCHED; PG8_LDA(At, 1, 0); PG8_STAGE(PG8_SA(0, 1), a2 + hstepA, voffA);
            PG8_WAIT_V(8); PG8_WAIT_L(0); PG8_BAR; PG8_MMA(0, 0, At, B0); PG8_MMA(0, 1, At, B1); PG8_BAR; PG8_SCHED;
            PG8_LDA(At, 1, 1); PG8_STAGE(PG8_SB(1, 0), b3, voffB); PG8_STAGE(PG8_SB(1, 1), b3 + hstep, voffB); PG8_STAGE(PG8_SA(1, 0), a3, voffA);
            PG8_WAIT_V(8); PG8_WAIT_L(0); PG8_BAR; PG8_MMA(1, 0, At, B0); PG8_MMA(1, 1, At, B1); PG8_BAR; PG8_SCHED;
            } else {
            PG8_LDB(B0, 0, 0); PG8_SCHED; PG8_LDA(At, 0, 0); PG8_STAGE(PG8_SA(1, 1), a1 + hstepA, voffA);
            PG8_WAIT_L(8); PG8_BAR; PG8_WAIT_L(0); PG8_MMA(0, 0, At, B0); PG8_BAR; PG8_SCHED;
            PG8_LDB(B1, 0, 1); PG8_STAGE(PG8_SB(0, 0), b2, voffB);
            PG8_BAR; PG8_WAIT_L(0); PG8_MMA(0, 1, At, B1); PG8_BAR;
            PG8_LDA(At, 0, 1); PG8_STAGE(PG8_SA(0, 0), a2, voffA);
            PG8_BAR; PG8_WAIT_L(0); PG8_MMA(1, 0, At, B0); PG8_BAR; PG8_SCHED;
            PG8_STAGE(PG8_SB(0, 1), b2 + hstep, voffB);
            PG8_WAIT_V(6); PG8_BAR; PG8_MMA(1, 1, At, B1); PG8_BAR;
            PG8_LDB(B0, 1, 0); PG8_SCHED; PG8_LDA(At, 1, 0); PG8_STAGE(PG8_SA(0, 1), a2 + hstepA, voffA);
            PG8_WAIT_L(8); PG8_BAR; PG8_WAIT_L(0); PG8_MMA(0, 0, At, B0); PG8_BAR; PG8_SCHED;
            PG8_LDB(B1, 1, 1); PG8_STAGE(PG8_SB(1, 0), b3, voffB);
            PG8_BAR; PG8_WAIT_L(0); PG8_MMA(0, 1, At, B1); PG8_BAR;
            PG8_LDA(At, 1, 1); PG8_STAGE(PG8_SA(1, 0), a3, voffA);
            PG8_BAR; PG8_WAIT_L(0); PG8_MMA(1, 0, At, B0); PG8_BAR; PG8_SCHED;
            PG8_STAGE(PG8_SB(1, 1), b3 + hstep, voffB);
            PG8_WAIT_V(6); PG8_BAR; PG8_MMA(1, 1, At, B1); PG8_BAR;
            }
        }
        if constexpr (ALIGN_EPI) { if (wr == 0) PG8_BAR; }
        if constexpr (!Epi::AFTER_DRAIN) { E(acc, cur, wr, wc, fr, fq); S.done(cur); }
        if (!has_next) break;
#pragma unroll
        for (int a = 0; a < 2; ++a)
#pragma unroll
            for (int b = 0; b < 2; ++b)
#pragma unroll
                for (int m = 0; m < 4; ++m)
#pragma unroll
                    for (int n = 0; n < 2; ++n) acc[a][b][m][n] = (f32x4){0.f, 0.f, 0.f, 0.f};
        cur = nxt; cA = nA; cB = nB; ++ui;
        if constexpr (ALIGN_EPI) { if (wr == 1) PG8_BAR; }
    }
    PG8_WAIT_V(0);
    if constexpr (!ALIGN_EPI) { if (wr == 0) PG8_BAR; }
    PG8_BAR;
    if constexpr (Epi::AFTER_DRAIN) { E.fused(acc, cur, wr, wc, fr, fq, lds, wid, lane); S.done(cur); }
#undef PG8_SA
#undef PG8_SB
#undef PG8_STAGE
#undef PG8_LDA
#undef PG8_LDB
#undef PG8_MMA
#undef PG8_WAIT_V
#undef PG8_WAIT_L
#undef PG8_BAR
#undef PG8_SCHED
}
}

#ifndef MK_ONE_LAUNCH
#define MK_ONE_LAUNCH 1
#endif
#define LAS __attribute__((address_space(3)))
typedef unsigned short bf16_t;
typedef short bf16x8 __attribute__((ext_vector_type(8)));
typedef short s16x4 __attribute__((ext_vector_type(4)));
typedef float f32x4 __attribute__((ext_vector_type(4)));
typedef unsigned u32x4 __attribute__((ext_vector_type(4)));
typedef unsigned u32x2 __attribute__((ext_vector_type(2)));

constexpr int BATCH = 8, SEQ = 2048, DM = 1024, TOK = BATCH * SEQ;
constexpr int D_IN = 6912, NQKV = 3840, NGATE = 3072, QPITCH = 1536, KPITCH = 1152, NVH = 18;
constexpr int DFF = 2816, CW0 = 1536, CW1 = 1280;
constexpr float RMS_EPS = 1e-6f;
constexpr float LOG2E = 1.4426950408889634f;
constexpr float QSCALE = 0.125f * LOG2E;
constexpr int NWAVES = 8, NTHREADS = 512;
constexpr size_t MiB = 1u << 20;
constexpr size_t WS_CTL = 0, CTL_BYTES = 32768;
constexpr size_t WS_ROPE = 1 * MiB;
constexpr size_t WS_KP = 1 * MiB + 512 * 1024;
constexpr size_t WS_WB = 2 * MiB, WB_LAYER = 35 * MiB;
constexpr size_t WB_IN = 0, WB_G = WB_IN + (size_t)NQKV * DM * 2, WB_BR = WB_G + (size_t)NGATE * DM * 2, WB_O = WB_BR + (size_t)3 * DM * 512 * 2,
                 WB_U = WB_O + (size_t)DM * DM * 2, WB_D = WB_U + (size_t)2 * DFF * DM * 2, WB_END = WB_D + (size_t)DM * DFF * 2;
static_assert(WB_END == WB_LAYER, "weight map");
constexpr size_t WS_H = 72 * MiB;
constexpr size_t WS_Q = 104 * MiB;
constexpr size_t WS_G = 152 * MiB;
constexpr size_t WS_K = 152 * MiB;
constexpr size_t WS_VT = 188 * MiB;
constexpr size_t WS_AH = 248 * MiB;
constexpr size_t WS_UH = 249 * MiB;
constexpr size_t WS_RS = 252 * MiB;
constexpr size_t RS_BYTES = (size_t)5 * TOK * 4;
constexpr size_t WS_END = 254 * MiB;
__device__ __forceinline__ float rs_of(float ss) { return __builtin_amdgcn_rsqf(ss * (1.f / DM) + RMS_EPS); }

__device__ __forceinline__ float bf2f(unsigned short b) { return __uint_as_float((unsigned)b << 16); }
__device__ __forceinline__ unsigned cvtpk(float lo, float hi) { return pg8::cvt_pk_bf16(lo, hi); }
__device__ __forceinline__ float fast_exp2(float x) { return __builtin_amdgcn_exp2f(x); }
__device__ __forceinline__ float fast_log2(float x) { return __builtin_amdgcn_logf(x); }
__device__ __forceinline__ float fast_rcp(float x) { return __builtin_amdgcn_rcpf(x); }

namespace pg8 {
struct EpiInproj {
    static constexpr bool PERM = false, AFTER_DRAIN = false;
    bf16_t* Q; bf16_t* Kb; bf16_t* VT; float* KP; const float* ropeC; const float* ropeS; const float* rss;
    __device__ __forceinline__ void operator()(const f32x4 (&acc)[2][2][4][2], const Unit& u, int wr, int wc, int fr, int fq) const {
        const int rbase = u.pm * BM + wr * 64 + fr;
#pragma unroll
        for (int bj = 0; bj < 2; ++bj) {
            const int gc0 = u.pn * BM + bj * HALF + wc * 32;
            int kind, dcol, pitch; bf16_t* dst; float sc = 1.f; int vh = 0; bool kp = false;
            if (gc0 < 1536) { dst = Q; pitch = QPITCH; dcol = gc0; sc = QSCALE; kind = (gc0 >= 512 && gc0 < 1024) ? 1 : 0; }
            else if (gc0 < 1664) { dst = Kb; pitch = KPITCH; dcol = gc0 - 1536; kind = 0; }
            else if (gc0 < 1792) { dst = VT; pitch = 0; dcol = 0; kind = 2; vh = (gc0 - 1664) >> 6; }
            else if (gc0 < 2304) { dst = Kb; pitch = KPITCH; dcol = 128 + (gc0 - 1792); kind = 1; }
            else if (gc0 < 2816) { dst = VT; pitch = 0; dcol = 0; kind = 2; vh = 2 + ((gc0 - 2304) >> 6); }
            else if (gc0 < 3328) { dst = Kb; pitch = KPITCH; dcol = 640 + (gc0 - 2816); kind = 0; kp = true; }
            else { dst = VT; pitch = 0; dcol = 0; kind = 2; vh = 10 + ((gc0 - 3328) >> 6); }
            if (kind == 0) {
                const int g = (gc0 >> 5) & 1, i0 = 16 * g + 4 * fq, hc = dcol & ~63;
                f32x4 s1 = {0.f, 0.f, 0.f, 0.f}, s2 = {0.f, 0.f, 0.f, 0.f};
#pragma unroll
                for (int ai = 0; ai < 2; ++ai)
#pragma unroll
                    for (int m = 0; m < 4; ++m) {
                        const int r = rbase + ai * HALF + m * 16, t = r & (SEQ - 1);
                        const f32x4 c4 = *(const f32x4*)(ropeC + t * 32 + i0), s4 = *(const f32x4*)(ropeS + t * 32 + i0);
                        const float rsv = rs_of(rss[r]);
                        const f32x4 x1 = acc[ai][bj][m][0] * rsv, x2 = acc[ai][bj][m][1] * rsv;
                        f32x4 o1 = x1 * c4 - x2 * s4, o2 = x2 * c4 + x1 * s4;
                        s1 += o1; s2 += o2;
                        o1 = o1 * sc; o2 = o2 * sc;
                        bf16_t* p = dst + (size_t)r * pitch + hc + i0;
                        u32x2 w1, w2; w1.x = cvt_pk_bf16(o1[0], o1[1]); w1.y = cvt_pk_bf16(o1[2], o1[3]); w2.x = cvt_pk_bf16(o2[0], o2[1]); w2.y = cvt_pk_bf16(o2[2], o2[3]);
                        *(u32x2*)p = w1; *(u32x2*)(p + 32) = w2;
                    }
                if (kp) {
#pragma unroll
                    for (int j = 0; j < 4; ++j) {
#pragma unroll
                        for (int o = 1; o < 16; o <<= 1) { s1[j] += __shfl_xor(s1[j], o); s2[j] += __shfl_xor(s2[j], o); }
                    }
                    if (fr == 0) { float* kpp = KP + (size_t)(u.pm * 2 + wr) * 512 + (hc - 640) + i0; *(f32x4*)kpp = s1; *(f32x4*)(kpp + 32) = s2; }
                }
            } else if (kind == 1) {
#pragma unroll
                for (int ai = 0; ai < 2; ++ai)
#pragma unroll
                    for (int m = 0; m < 4; ++m) {
                        const int r = rbase + ai * HALF + m * 16; const float rsv = rs_of(rss[r]) * sc;
#pragma unroll
                        for (int n = 0; n < 2; ++n) { const f32x4 v = acc[ai][bj][m][n] * rsv; u32x2 w; w.x = cvt_pk_bf16(v[0], v[1]); w.y = cvt_pk_bf16(v[2], v[3]);
                            *(u32x2*)(dst + (size_t)r * pitch + dcol + 16 * n + 4 * fq) = w; }
                    }
            } else {
#pragma unroll
                for (int ai = 0; ai < 2; ++ai)
#pragma unroll
                    for (int m = 0; m < 4; ++m) {
                        const int r = rbase + ai * HALF + m * 16, b = r >> 11, t = r & (SEQ - 1); const float rsv = rs_of(rss[r]);
#pragma unroll
                        for (int n = 0; n < 2; ++n) {
                            const int d0 = (gc0 & 32) + 16 * n + 4 * fq;
                            bf16_t* p = dst + ((size_t)(b * NVH + vh) * 64 + d0) * SEQ + t;
                            const f32x4 v = acc[ai][bj][m][n] * rsv;
                            const unsigned w0 = cvt_pk_bf16(v[0], v[1]), w1 = cvt_pk_bf16(v[2], v[3]);
                            p[0] = (bf16_t)(w0 & 0xffffu); p[SEQ] = (bf16_t)(w0 >> 16); p[2 * SEQ] = (bf16_t)(w1 & 0xffffu); p[3 * SEQ] = (bf16_t)(w1 >> 16);
                        }
                    }
            }
        }
    }
};
template <int ACT> struct EpiRowBf16 {
    static constexpr bool PERM = false, AFTER_DRAIN = false;
    bf16_t* O; int ldc; const float* bias; const float* rss;
    __device__ __forceinline__ void operator()(const f32x4 (&acc)[2][2][4][2], const Unit& u, int wr, int wc, int fr, int fq) const {
        const int row0 = u.pm * BM + wr * 64 + fr, col0 = u.pn * BM + wc * 32 + 4 * fq;
        f32x4 bv[2][2];
#pragma unroll
        for (int bj = 0; bj < 2; ++bj)
#pragma unroll
            for (int n = 0; n < 2; ++n) bv[bj][n] = bias ? *(const f32x4*)(bias + col0 + bj * HALF + 16 * n) : (f32x4){0.f, 0.f, 0.f, 0.f};
#pragma unroll
        for (int ai = 0; ai < 2; ++ai)
#pragma unroll
            for (int m = 0; m < 4; ++m) { bf16_t* rowp = O + (size_t)(row0 + ai * HALF + m * 16) * ldc + col0; const float rsv = rs_of(rss[row0 + ai * HALF + m * 16]);
#pragma unroll
                for (int bj = 0; bj < 2; ++bj)
#pragma unroll
                    for (int n = 0; n < 2; ++n) { f32x4 v0 = acc[ai][bj][m][n] * rsv + bv[bj][n];
                        if (ACT == 2) {
#pragma unroll
                            for (int j = 0; j < 4; ++j) v0[j] = __builtin_amdgcn_rcpf(1.f + __builtin_amdgcn_exp2f(-LOG2E * v0[j]));
                        }
                        u32x2 w; w.x = cvt_pk_bf16(v0[0], v0[1]); w.y = cvt_pk_bf16(v0[2], v0[3]);
                        *(u32x2*)(rowp + bj * HALF + 16 * n) = w; } }
    }
};
struct EpiBranch {
    static constexpr bool PERM = false, AFTER_DRAIN = false;
    bf16_t* Mo; const bf16_t* G; int goff; int accum;
    __device__ __forceinline__ void operator()(const f32x4 (&acc)[2][2][4][2], const Unit& u, int wr, int wc, int fr, int fq) const {
        const int row0 = u.pm * BM + wr * 64 + fr, col0 = u.pn * BM + wc * 32 + 4 * fq;
#pragma unroll
        for (int ai = 0; ai < 2; ++ai)
#pragma unroll
            for (int m = 0; m < 4; ++m) { const size_t r = (size_t)(row0 + ai * HALF + m * 16);
#pragma unroll
                for (int bj = 0; bj < 2; ++bj)
#pragma unroll
                    for (int n = 0; n < 2; ++n) {
                        const int c = col0 + bj * HALF + 16 * n;
                        const u32x2 gv = *(const u32x2*)(G + r * NGATE + goff + c);
                        u32x2 mv = {0u, 0u}; if (accum) mv = *(const u32x2*)(Mo + r * DM + c);
                        const f32x4 a0 = acc[ai][bj][m][n];
                        float o[4];
#pragma unroll
                        for (int k = 0; k < 2; ++k) {
                            const unsigned gw = gv[k], mw = mv[k];
                            o[2 * k] = __uint_as_float(mw << 16) + __uint_as_float(gw << 16) * a0[2 * k];
                            o[2 * k + 1] = __uint_as_float(mw & 0xffff0000u) + __uint_as_float(gw & 0xffff0000u) * a0[2 * k + 1];
                        }
                        u32x2 w; w.x = cvt_pk_bf16(o[0], o[1]); w.y = cvt_pk_bf16(o[2], o[3]);
                        *(u32x2*)(Mo + r * DM + c) = w; } }
    }
};
struct EpiResidual {
    static constexpr bool PERM = false, AFTER_DRAIN = false;
    const float* base; float* out;
    __device__ __forceinline__ void operator()(const f32x4 (&acc)[2][2][4][2], const Unit& u, int wr, int wc, int fr, int fq) const {
        const int col0 = u.pn * BM + wc * 32 + 4 * fq;
#pragma unroll
        for (int ai = 0; ai < 2; ++ai)
#pragma unroll
            for (int m = 0; m < 4; ++m) { const size_t off = (size_t)(u.pm * BM + ai * HALF + wr * 64 + m * 16 + fr) * DM + col0;
#pragma unroll
                for (int bj = 0; bj < 2; ++bj)
#pragma unroll
                    for (int n = 0; n < 2; ++n) { const f32x4 bs = *(const f32x4*)(base + off + bj * HALF + n * 16); *(f32x4*)(out + off + bj * HALF + n * 16) = bs + acc[ai][bj][m][n]; } }
    }
};

struct EpiHalo {
    static constexpr bool PERM = false, AFTER_DRAIN = false;
    float* UH; const float* rss;
    __device__ __forceinline__ void operator()(const f32x4 (&acc)[2][2][4][2], const Unit& u, int wr, int wc, int fr, int fq) const {
        const int col0 = u.pn * BM + wc * 32 + 4 * fq;
#pragma unroll
        for (int m = 0; m < 4; ++m) { const int rho = wr * 64 + m * 16 + fr; const size_t off = (size_t)rho * (2 * DFF) + col0;
            int tok = 256 * (rho >> 1) - 2 + (rho & 1); if (tok < 0) tok = 0; const float rsv = rs_of(rss[tok]);
#pragma unroll
            for (int bj = 0; bj < 2; ++bj)
#pragma unroll
                for (int n = 0; n < 2; ++n) *(f32x4*)(UH + off + bj * HALF + n * 16) = acc[0][bj][m][n] * rsv; }
    }
};
struct EpiUpConv {
    static constexpr bool PERM = false, AFTER_DRAIN = false;
    bf16_t* ACT; const float* UH; const float* cw; const float* cb; LAS float* X; const float* rss;
    __device__ __forceinline__ void operator()(const f32x4 (&acc)[2][2][4][2], const Unit& u, int wr, int wc, int fr, int fq) const {
        const int lane = fr + 16 * fq, cl = wc * 32 + 4 * fq;
        const float* rsp = rss + u.pm * BM + wr * 64 + fr;
        if (fr >= 14) {
            float rsr[2][4];
#pragma unroll
            for (int ai = 0; ai < 2; ++ai) rsr[ai][3] = rs_of(rsp[ai * HALF + 48]);
#pragma unroll
            for (int ai = 0; ai < 2; ++ai)
#pragma unroll
                for (int bj = 0; bj < 2; ++bj)
#pragma unroll
                    for (int n = 0; n < 2; ++n) *(LAS f32x4*)(X + ((ai * 2 + wr) * 2 + (fr - 14)) * 256 + bj * HALF + cl + 16 * n) = acc[ai][bj][3][n] * rsr[ai][3];
        }
        asm volatile("s_waitcnt lgkmcnt(0)\n\ts_barrier" ::: "memory");
        const bool seqstart = (u.pm & 7) == 0;
        const int src1 = (lane & 48) | ((fr + 15) & 15), src2 = (lane & 48) | ((fr + 14) & 15);
#pragma unroll
        for (int n = 0; n < 2; ++n) {
            const int ch = u.pn * HALF + cl + 16 * n;
            const f32x4 wa0 = *(const f32x4*)(cw + ch), wa1 = *(const f32x4*)(cw + 2 * DFF + ch), wa2 = *(const f32x4*)(cw + 4 * DFF + ch);
            const f32x4 wv0 = *(const f32x4*)(cw + DFF + ch), wv1 = *(const f32x4*)(cw + 3 * DFF + ch), wv2 = *(const f32x4*)(cw + 5 * DFF + ch);
            const f32x4 ba = *(const f32x4*)(cb + ch), bv = *(const f32x4*)(cb + DFF + ch);
#pragma unroll
            for (int ai = 0; ai < 2; ++ai) {
                const int blk = ai * 2 + wr;
                f32x4 Ba1 = {0.f, 0.f, 0.f, 0.f}, Ba2 = Ba1, Bv1 = Ba1, Bv2 = Ba1;
                if (blk > 0) { const LAS float* xp = X + (blk - 1) * 512 + cl + 16 * n;
                    Ba2 = *(const LAS f32x4*)xp; Ba1 = *(const LAS f32x4*)(xp + 256); Bv2 = *(const LAS f32x4*)(xp + HALF); Bv1 = *(const LAS f32x4*)(xp + 256 + HALF); }
                else if (!seqstart) { const float* hp = UH + (size_t)(2 * u.pm) * (2 * DFF) + u.pn * BM + cl + 16 * n;
                    Ba2 = *(const f32x4*)hp; Ba1 = *(const f32x4*)(hp + 2 * DFF); Bv2 = *(const f32x4*)(hp + HALF); Bv1 = *(const f32x4*)(hp + 2 * DFF + HALF); }
                f32x4 pa1 = Ba1, pa2 = (fr == 0) ? Ba2 : Ba1, pv1 = Bv1, pv2 = (fr == 0) ? Bv2 : Bv1;
#pragma unroll
                for (int m = 0; m < 4; ++m) {
                    const float rsv = rs_of(rsp[ai * HALF + m * 16]);
                    f32x4 ca;
                    { const f32x4 ca0 = acc[ai][0][m][n] * rsv; f32x4 sa1, sa2;
#pragma unroll
                      for (int j = 0; j < 4; ++j) { sa1[j] = __shfl(ca0[j], src1); sa2[j] = __shfl(ca0[j], src2); }
                      const f32x4 a1 = (fr >= 1) ? sa1 : pa1, a2 = (fr >= 2) ? sa2 : pa2;
                      ca = ba + wa0 * a2 + wa1 * a1 + wa2 * ca0; pa1 = sa1; pa2 = sa2;
#pragma unroll
                      for (int j = 0; j < 4; ++j) ca[j] = ca[j] * __builtin_amdgcn_rcpf(1.f + __builtin_amdgcn_exp2f(-LOG2E * ca[j])); }

                    { const f32x4 cv0 = acc[ai][1][m][n] * rsv; f32x4 sv1, sv2;
#pragma unroll
                      for (int j = 0; j < 4; ++j) { sv1[j] = __shfl(cv0[j], src1); sv2[j] = __shfl(cv0[j], src2); }
                      const f32x4 v1 = (fr >= 1) ? sv1 : pv1, v2 = (fr >= 2) ? sv2 : pv2;
                      const f32x4 cv = bv + wv0 * v2 + wv1 * v1 + wv2 * cv0; pv1 = sv1; pv2 = sv2;
                      const f32x4 o = ca * cv;
                      u32x2 w; w.x = cvt_pk_bf16(o[0], o[1]); w.y = cvt_pk_bf16(o[2], o[3]);
                      *(u32x2*)(ACT + (size_t)(u.pm * BM + ai * HALF + wr * 64 + m * 16 + fr) * DFF + ch) = w; }
                    asm volatile("" ::: "memory");
                }
            }
        }
    }
};
struct EpiResidualNorm {
    static constexpr bool PERM = false, AFTER_DRAIN = false;
    const float* base; float* out; bf16_t* XG; const float* g; float* rss; bf16_t* AH;
    __device__ __forceinline__ void operator()(const f32x4 (&acc)[2][2][4][2], const Unit& u, int wr, int wc, int fr, int fq) const {
        const int col0 = u.pn * BM + wc * 32 + 4 * fq;
        f32x4 gv[2][2];
#pragma unroll
        for (int bj = 0; bj < 2; ++bj)
#pragma unroll
            for (int n = 0; n < 2; ++n) gv[bj][n] = g ? *(const f32x4*)(g + col0 + bj * HALF + n * 16) : (f32x4){0.f, 0.f, 0.f, 0.f};
#pragma unroll
        for (int ai = 0; ai < 2; ++ai)
#pragma unroll
            for (int m = 0; m < 4; ++m) { const int r = u.pm * BM + ai * HALF + wr * 64 + m * 16 + fr; const size_t off = (size_t)r * DM + col0;
                bf16_t* hrow = nullptr; if (AH && (r & 255) >= 254 && (r >> 8) < 63) hrow = AH + (size_t)(2 * ((r >> 8) + 1) + (r & 255) - 254) * DM + col0;
                float ss = 0.f;
#pragma unroll
                for (int bj = 0; bj < 2; ++bj)
#pragma unroll
                    for (int n = 0; n < 2; ++n) { const f32x4 bs = *(const f32x4*)(base + off + bj * HALF + n * 16); const f32x4 xn = bs + acc[ai][bj][m][n];
                        *(f32x4*)(out + off + bj * HALF + n * 16) = xn;
                        ss += (xn[0] * xn[0] + xn[1] * xn[1]) + (xn[2] * xn[2] + xn[3] * xn[3]);
                        if (XG) { const f32x4 y = xn * gv[bj][n]; u32x2 w; w.x = cvt_pk_bf16(y[0], y[1]); w.y = cvt_pk_bf16(y[2], y[3]);
                            *(u32x2*)(XG + off + bj * HALF + n * 16) = w; if (hrow) *(u32x2*)(hrow + bj * HALF + n * 16) = w; } }
                ss += __shfl_xor(ss, 16); ss += __shfl_xor(ss, 32);
                if (fq == 0) atomicAdd(rss + r, ss);
            }
    }
};
}
#define XB_TMO      128
#define XB_XCNT(j)  (256  + 64 * (j))
#define XB_XSUB(j)  (1280 + 64 * (j))
#define XB_XGEN(j)  (2304 + 64 * (j))
#define XB_TOP      3328
#define XB_TOPGEN   3392
#define XCD_BAR_WORDS 3456
#define XB_SPIN_CAP (1u << 18)

__device__ __forceinline__ unsigned xb_ld(unsigned* p)              { return __hip_atomic_load(p, __ATOMIC_RELAXED, __HIP_MEMORY_SCOPE_AGENT); }
__device__ __forceinline__ unsigned xb_add(unsigned* p, unsigned v) { return __hip_atomic_fetch_add(p, v, __ATOMIC_RELAXED, __HIP_MEMORY_SCOPE_AGENT); }
__device__ __forceinline__ unsigned xb_xcc_id() { return (unsigned)__builtin_amdgcn_s_getreg((3 << 11) | 20) & 0xFu; }
#define XB_SPIN(cond, bar) do { unsigned _sp = 0; while (cond) { __builtin_amdgcn_s_sleep(1); \
    if ((++_sp & 255u) == 0u) { if (xb_ld(&(bar)[XB_TMO])) break; if (_sp > XB_SPIN_CAP) { atomicAdd(&(bar)[XB_TMO], 1u); break; } } } } while (0)

struct XcdBarrier {
    unsigned* bar; unsigned x;
    volatile LAS unsigned* st;
};

__device__ __forceinline__ XcdBarrier xcd_barrier_post(unsigned* bar, volatile LAS unsigned* st) {
    XcdBarrier b; b.bar = bar; b.x = xb_xcc_id(); b.st = st;
    if (threadIdx.x == 0) (void)xb_add(&bar[XB_XCNT(b.x)], 1u);
    return b;
}
__device__ __forceinline__ void xcd_barrier_complete(unsigned* bar, unsigned x, unsigned& nloc, unsigned& nx) {
    const unsigned G = gridDim.x * gridDim.y * gridDim.z;
    unsigned sum, cnt, mine, sp = 0u;
    for (;;) {
        sum = 0u; cnt = 0u; mine = 0u;
#pragma unroll
        for (unsigned j = 0; j < 16; ++j) { const unsigned c = xb_ld(&bar[XB_XCNT(j)]); sum += c; cnt += (c > 0u) ? 1u : 0u; mine = (j == x) ? c : mine; }
        if (sum == G) break;
        __builtin_amdgcn_s_sleep(1);
        if ((++sp & 255u) == 0u) { if (xb_ld(&bar[XB_TMO])) break; if (sp > XB_SPIN_CAP) { atomicAdd(&bar[XB_TMO], 1u); break; } }
    }
    nloc = mine > 0u ? mine : 1u; nx = cnt > 0u ? cnt : 1u;
}

__device__ __forceinline__ void xcd_barrier(const XcdBarrier& b) {
    asm volatile("s_waitcnt vmcnt(0)" ::: "memory");
    __syncthreads();
    if (threadIdx.x == 0) {
        unsigned* bar = b.bar;
        __builtin_amdgcn_s_waitcnt(0);
        unsigned nloc = b.st[0], nx = b.st[1];
        if (nloc == 0u) { xcd_barrier_complete(bar, b.x, nloc, nx); b.st[0] = nloc; b.st[1] = nx; }
        const unsigned old = xb_add(&bar[XB_XSUB(b.x)], 1u);
        const unsigned gen = old / nloc;
        if (old + 1u == (gen + 1u) * nloc) {
            __builtin_amdgcn_fence(__ATOMIC_RELEASE, "agent");
            asm volatile("s_waitcnt vmcnt(0)" ::: "memory");
            const unsigned og = xb_add(&bar[XB_TOP], 1u);
            const unsigned tg = og / nx;
            if (og + 1u == (tg + 1u) * nx) xb_add(&bar[XB_TOPGEN], 1u);
            else XB_SPIN(xb_ld(&bar[XB_TOPGEN]) == tg, bar);
            __builtin_amdgcn_fence(__ATOMIC_ACQUIRE, "agent");
            xb_add(&bar[XB_XGEN(b.x)], 1u);
            asm volatile("s_waitcnt vmcnt(0)" ::: "memory");
        } else {
            XB_SPIN(xb_ld(&bar[XB_XGEN(b.x)]) == gen, bar);
            __builtin_amdgcn_fence(__ATOMIC_ACQUIRE, "agent");
            asm volatile("s_waitcnt vmcnt(0)" ::: "memory");
        }
    }
    __syncthreads();
}
namespace att {
constexpr int LP = 72;
constexpr int VP = 136;
constexpr int KT_BYTES = 128 * LP * 2;
constexpr int VT_BYTES = 64 * VP * 2;
constexpr int BUF_BYTES = KT_BYTES + VT_BYTES;
constexpr int KM_OFF = 2 * BUF_BYTES;
constexpr int UNIT_OFF = KM_OFF + 2048;
constexpr int DONE_OFF = UNIT_OFF + 64;
constexpr int NUNITS = 3 * 1024;
__device__ __forceinline__ f32x4 mfma16(bf16x8 a, bf16x8 b, f32x4 c) { return __builtin_amdgcn_mfma_f32_16x16x32_bf16(a, b, c, 0, 0, 0); }

template <int MODE>
__device__ __forceinline__ void attn_unit(LAS unsigned char* lds, bf16_t* Qb, const bf16_t* Kb, const bf16_t* VT, const float* KP, const float* sinks, int b, int h, int qt, bool dry = false) {
    int tid_ = threadIdx.x; asm volatile("" : "+v"(tid_));
    const int tid = tid_, lane = tid & 63, wid = __builtin_amdgcn_readfirstlane(tid >> 6), l15 = lane & 15, q4 = lane >> 4;
    const int t0 = qt * 128, tw = t0 + 16 * wid, tq = tw + l15;
    const size_t rowq = (size_t)b * SEQ + tq;
    int qcol, kcol, vh;
    if (MODE == 0) { qcol = h * 64; kcol = (h >> 2) * 64; vh = h >> 2; }
    else if (MODE == 1) { qcol = 512 + h * 64; kcol = 128 + h * 64; vh = 2 + h; }
    else { qcol = 1024 + h * 64; kcol = 640 + h * 64; vh = 10 + h; }
    bf16_t* Qrow = Qb + rowq * QPITCH + qcol;
    bf16x8 qf[2];
    qf[0] = *(const bf16x8*)(Qrow + 8 * q4); qf[1] = *(const bf16x8*)(Qrow + 32 + 8 * q4);
    const bf16_t* Kg = Kb + (size_t)b * SEQ * KPITCH + kcol;
    const bf16_t* Vg = VT + (size_t)(b * NVH + vh) * 64 * SEQ;
    const int srow = tid >> 3, sch = tid & 7;
    const int Tlast = qt;
    int Tfirst = 0; if (MODE == 0) { Tfirst = qt - 1; if (Tfirst < 0) Tfirst = 0; }
    const int nT = Tlast - Tfirst + 1;
    const int srow2 = tid >> 4, sch2 = tid & 15;
    unsigned sel = 0u; const int jblk = t0 >> 8;
    if (MODE == 2) {
        LAS float* km = (LAS float*)(lds + KM_OFF);
        { const int n = tid >> 6, d = tid & 63; float v = 0.f;
          if (n < jblk) { const float* p = KP + (size_t)((b * 8 + n) * 2) * 512 + h * 64 + d; v = p[0] + p[512]; }
          km[n * 64 + d] = v; }
        __syncthreads();
        float g0 = 0.f, g1 = 0.f;
#pragma unroll
        for (int k = 0; k < 8; ++k) { const bf16x8 qv = *(const bf16x8*)(Qrow + 8 * k);
#pragma unroll
            for (int e = 0; e < 8; ++e) { const float qe = bf2f((unsigned short)qv[e]); g0 += qe * km[q4 * 64 + 8 * k + e]; g1 += qe * km[(q4 + 4) * 64 + 8 * k + e]; } }
        float g[8];
#pragma unroll
        for (int n = 0; n < 8; ++n) g[n] = __shfl((n < 4) ? g0 : g1, l15 + 16 * (n & 3));
#pragma unroll
        for (int n = 0; n < 8; ++n) { int cnt = 0;
#pragma unroll
            for (int n2 = 0; n2 < 8; ++n2) if (n2 != n) cnt += (n2 < jblk && ((g[n2] > g[n]) || (g[n2] == g[n] && n2 < n))) ? 1 : 0;
            if (n < jblk && cnt < 3) sel |= (1u << n); }
    }
    bf16x8 u00, u10, u21, u31, uall;
    if (MODE == 1) {
#pragma unroll
        for (int j = 0; j < 8; ++j) { const int kin = 16 * (j >> 2) + 4 * q4 + (j & 3);
            u00[j] = (kin >= l15) ? (short)0x3F80 : (short)0; u10[j] = (kin >= 16 + l15) ? (short)0x3F80 : (short)0;
            u21[j] = (kin >= l15) ? (short)0x3F80 : (short)0; u31[j] = (kin >= 16 + l15) ? (short)0x3F80 : (short)0; uall[j] = (short)0x3F80; }
    }
    float mrun = -1e30f, lsum = 0.f, carry = 0.f; bool sbdone = false;
    if (MODE == 0) { mrun = sinks[h] * LOG2E; lsum = (q4 == 0) ? 1.f : 0.f; }
    f32x4 o[4];
#pragma unroll
    for (int dd = 0; dd < 4; ++dd) o[dd] = (f32x4){0.f, 0.f, 0.f, 0.f};
    u32x4 kreg0, kreg1, vreg0, vreg1;
#define ATT_LOAD(ks_) do { kreg0 = *(const u32x4*)(Kg + (size_t)((ks_) + srow) * KPITCH + sch * 8); kreg1 = *(const u32x4*)(Kg + (size_t)((ks_) + 64 + srow) * KPITCH + sch * 8); \
        vreg0 = *(const u32x4*)(Vg + (size_t)srow2 * SEQ + (ks_) + sch2 * 8); vreg1 = *(const u32x4*)(Vg + (size_t)(32 + srow2) * SEQ + (ks_) + sch2 * 8); } while (0)
#define ATT_STORE(buf_) do { LAS unsigned char* b_ = lds + (buf_) * BUF_BYTES; *(LAS u32x4*)(b_ + (srow * LP + sch * 8) * 2) = kreg0; *(LAS u32x4*)(b_ + ((64 + srow) * LP + sch * 8) * 2) = kreg1; \
        *(LAS u32x4*)(b_ + KT_BYTES + (srow2 * VP + sch2 * 8) * 2) = vreg0; *(LAS u32x4*)(b_ + KT_BYTES + ((32 + srow2) * VP + sch2 * 8) * 2) = vreg1; } while (0)
    { const int T = (MODE == 1) ? Tlast : Tfirst; ATT_LOAD(128 * T); ATT_STORE(0); }
    __syncthreads();
    for (int i = 0; i < nT; ++i) {
        const int T = (MODE == 1) ? (Tlast - i) : (Tfirst + i);
        if (i + 1 < nT) { const int Tn = (MODE == 1) ? (T - 1) : (T + 1); ATT_LOAD(128 * Tn); }
#pragma unroll
        for (int hh = 0; hh < 2; ++hh) {
        const int h2 = (MODE == 1) ? (1 - hh) : hh, ks = 128 * T + 64 * h2;
        LAS unsigned char* Kl = lds + (i & 1) * BUF_BYTES + h2 * (64 * LP * 2); LAS unsigned char* Vl = lds + (i & 1) * BUF_BYTES + KT_BYTES + h2 * 128;
        bool need;
        if (MODE == 0) need = (ks <= tw + 15) && (ks + 63 > tw - 128);
        else if (MODE == 1) need = (ks < tw + 15) && !sbdone;
        else need = (ks <= tw + 15);
        if (need) {
            f32x4 st[4];
#pragma unroll
            for (int s = 0; s < 4; ++s) { st[s] = (f32x4){0.f, 0.f, 0.f, 0.f};
#pragma unroll
                for (int c = 0; c < 2; ++c) { const bf16x8 a = *(const LAS bf16x8*)(Kl + ((16 * s + l15) * LP + 32 * c + 8 * q4) * 2); st[s] = mfma16(a, qf[c], st[s]); } }
            bf16x8 pf[2];
            if (MODE != 1) {
                bool blkok = true; const bool pastblk = (MODE == 2) && ((ks >> 8) < jblk); if (MODE == 2) { const int n = ks >> 8; if (n < jblk) blkok = ((sel >> n) & 1u) != 0u; }
                float mx = -INFINITY;
#pragma unroll
                for (int s = 0; s < 4; ++s)
#pragma unroll
                    for (int r = 0; r < 4; ++r) { const int key = ks + 16 * s + 4 * q4 + r; bool ok;
                        if (MODE == 0) ok = (key <= tq) && (key > tq - 128); else ok = blkok && (pastblk || key <= tq);
                        const float v = ok ? st[s][r] : -INFINITY; st[s][r] = v; mx = fmaxf(mx, v); }
                mx = fmaxf(mx, __shfl_xor(mx, 16)); mx = fmaxf(mx, __shfl_xor(mx, 32));
                const float mnew = fmaxf(mrun, mx), alpha = fast_exp2(mrun - mnew); mrun = mnew;
                float ps = 0.f;
#pragma unroll
                for (int s = 0; s < 4; ++s)
#pragma unroll
                    for (int r = 0; r < 4; ++r) { const float p = fast_exp2(st[s][r] - mnew); st[s][r] = p; ps += p; }
                lsum = lsum * alpha + ps;
#pragma unroll
                for (int dd = 0; dd < 4; ++dd) o[dd] = o[dd] * alpha;
            } else {
                float sp[4][4]; bf16x8 bh[2], bl[2];
#pragma unroll
                for (int s = 0; s < 4; ++s)
#pragma unroll
                    for (int r = 0; r < 4; ++r) { const int key = ks + 16 * s + 4 * q4 + r; const float z = st[s][r];
                        float v = fmaxf(z, 0.f) + fast_log2(1.f + fast_exp2(-fabsf(z))); sp[s][r] = (key < tq) ? v : 0.f; }
#pragma unroll
                for (int c = 0; c < 2; ++c) { u32x4 wh, wl;
#pragma unroll
                    for (int k = 0; k < 4; ++k) { const int s = 2 * c + (k >> 1), r = 2 * (k & 1);
                        const unsigned hw = cvtpk(sp[s][r], sp[s][r + 1]);
                        const float l0 = sp[s][r] - __uint_as_float(hw << 16), l1 = sp[s][r + 1] - __uint_as_float(hw & 0xffff0000u);
                        wh[k] = hw; wl[k] = cvtpk(l0, l1); }
                    bh[c] = __builtin_bit_cast(bf16x8, wh); bl[c] = __builtin_bit_cast(bf16x8, wl); }
                f32x4 ct[4];
#pragma unroll
                for (int s = 0; s < 4; ++s) ct[s] = (f32x4){carry, carry, carry, carry};
                ct[0] = mfma16(u00, bh[0], ct[0]); ct[0] = mfma16(u00, bl[0], ct[0]); ct[0] = mfma16(uall, bh[1], ct[0]); ct[0] = mfma16(uall, bl[1], ct[0]);
                ct[1] = mfma16(u10, bh[0], ct[1]); ct[1] = mfma16(u10, bl[0], ct[1]); ct[1] = mfma16(uall, bh[1], ct[1]); ct[1] = mfma16(uall, bl[1], ct[1]);
                ct[2] = mfma16(u21, bh[1], ct[2]); ct[2] = mfma16(u21, bl[1], ct[2]);
                ct[3] = mfma16(u31, bh[1], ct[3]); ct[3] = mfma16(u31, bl[1], ct[3]);
#pragma unroll
                for (int s = 0; s < 4; ++s)
#pragma unroll
                    for (int r = 0; r < 4; ++r) { const int key = ks + 16 * s + 4 * q4 + r; const float w = fast_exp2(st[s][r] - ct[s][r]); st[s][r] = (key < tq) ? w : 0.f; }
                carry = __shfl(ct[0][0], l15);
                { float cm = carry; cm = fminf(cm, __shfl_xor(cm, 1)); cm = fminf(cm, __shfl_xor(cm, 2)); cm = fminf(cm, __shfl_xor(cm, 4)); cm = fminf(cm, __shfl_xor(cm, 8)); sbdone = cm > 48.f; }
            }
#pragma unroll
            for (int c = 0; c < 2; ++c) { u32x4 w; w.x = cvtpk(st[2 * c][0], st[2 * c][1]); w.y = cvtpk(st[2 * c][2], st[2 * c][3]); w.z = cvtpk(st[2 * c + 1][0], st[2 * c + 1][1]); w.w = cvtpk(st[2 * c + 1][2], st[2 * c + 1][3]);
                pf[c] = __builtin_bit_cast(bf16x8, w); }
#pragma unroll
            for (int dd = 0; dd < 4; ++dd)
#pragma unroll
                for (int c = 0; c < 2; ++c) {
                    const s16x4 v0 = *(const LAS s16x4*)(Vl + ((16 * dd + l15) * VP + 32 * c + 4 * q4) * 2), v1 = *(const LAS s16x4*)(Vl + ((16 * dd + l15) * VP + 32 * c + 16 + 4 * q4) * 2);
                    const bf16x8 a = {v0[0], v0[1], v0[2], v0[3], v1[0], v1[1], v1[2], v1[3]};
                    o[dd] = mfma16(a, pf[c], o[dd]); }
        }
        }
        if (i + 1 < nT) ATT_STORE((i + 1) & 1);
        if (MODE == 1) { if (lane == 0) ((LAS int*)(lds + DONE_OFF))[wid * 2 + (i & 1)] = sbdone ? 1 : 0; }
        __syncthreads();
        if (MODE == 1) { const LAS int* df = (const LAS int*)(lds + DONE_OFF) + (i & 1); int all = 1;
#pragma unroll
            for (int w = 0; w < 8; ++w) all &= df[2 * w];
            if (all) break; }
    }
    if (MODE == 1) __syncthreads();
#undef ATT_LOAD
#undef ATT_STORE
    float inv = 1.f;
    if (MODE != 1) { lsum += __shfl_xor(lsum, 16); lsum += __shfl_xor(lsum, 32); inv = 1.f / lsum; }
    if (!dry || lsum == 12345.678f)
#pragma unroll
    for (int dd = 0; dd < 4; ++dd) { const f32x4 v = o[dd] * inv; u32x2 w; w.x = cvtpk(v[0], v[1]); w.y = cvtpk(v[2], v[3]); *(u32x2*)(Qrow + 16 * dd + 4 * q4) = w; }
}

__device__ __forceinline__ void attn_phase(LAS unsigned char* lds, bf16_t* Qb, const bf16_t* Kb, const bf16_t* VT, const float* KP, const float* sinks, unsigned* ctr, bool dry = false) {
    LAS int* uw = (LAS int*)(lds + UNIT_OFF);
    for (;;) {
        if (threadIdx.x == 0) uw[0] = (int)atomicAdd(ctr, 1u);
        __syncthreads();
        const int idx = uw[0];
        __syncthreads();
        if (idx >= NUNITS) break;
        if (idx < 2048) { const int qt = 15 - (idx >> 7), mode = 1 + (idx & 1), bh = (idx >> 1) & 63;
            if (mode == 1) attn_unit<1>(lds, Qb, Kb, VT, KP, sinks, bh >> 3, bh & 7, qt, dry); else attn_unit<2>(lds, Qb, Kb, VT, KP, sinks, bh >> 3, bh & 7, qt, dry); }
        else { const int ii = idx - 2048, qt = ii >> 6, bh = ii & 63; attn_unit<0>(lds, Qb, Kb, VT, KP, sinks, bh >> 3, bh & 7, qt, dry); }
    }
}
}
__device__ __forceinline__ float wave_sum(float v) {
#pragma unroll
    for (int o = 1; o < 64; o <<= 1) v += __shfl_xor(v, o);
    return v;
}
template <bool OUT_F32> __device__ __forceinline__ void rms_row(const float* xrow, const float* g, void* orow, int lane, bf16_t* hrow = nullptr) {
    const f32x4* xr = (const f32x4*)xrow + lane; const f32x4* gr = (const f32x4*)g + lane;
    f32x4 v[4]; float s = 0.f;
#pragma unroll
    for (int j = 0; j < 4; ++j) { v[j] = xr[64 * j]; s += (v[j].x * v[j].x + v[j].y * v[j].y) + (v[j].z * v[j].z + v[j].w * v[j].w); }
    const float rs = 1.0f / sqrtf(wave_sum(s) * (1.f / DM) + RMS_EPS);
#pragma unroll
    for (int j = 0; j < 4; ++j) { const f32x4 y = v[j] * rs * gr[64 * j];
        if (OUT_F32) ((f32x4*)orow)[lane + 64 * j] = y;
        else { u32x2 w; w.x = cvtpk(y.x, y.y); w.y = cvtpk(y.z, y.w); ((u32x2*)orow)[lane + 64 * j] = w; if (hrow) ((u32x2*)hrow)[lane + 64 * j] = w; } }
}
template <bool OUT_F32> __device__ __forceinline__ void rms_phase(const float* x, const float* g, void* out, int gw, int NGW, int lane, bf16_t* AH = nullptr) {
    asm volatile("" : "+v"(lane));
    for (int m = gw; m < TOK; m += NGW) { bf16_t* hrow = nullptr; if (AH && (m & 255) >= 254 && (m >> 8) < 63) hrow = AH + (size_t)(2 * ((m >> 8) + 1) + (m & 255) - 254) * DM;
        rms_row<OUT_F32>(x + (size_t)m * DM, g, OUT_F32 ? (void*)((float*)out + (size_t)m * DM) : (void*)((bf16_t*)out + (size_t)m * DM), lane, hrow); }
}
__device__ __forceinline__ int ropeperm(int c) { const int cp = c & 63; return (c & ~63) + 16 * (cp >> 5) + (cp & 15) + 32 * ((cp >> 4) & 1); }
template <int MAP> __device__ __forceinline__ int map_col(int n) {
    if (MAP == 0) return n;
    if (MAP == 1) {
        if (n < 512) return ropeperm(n);
        if (n < 1024) return 768 + (n - 512);
        if (n < 1536) return 2304 + ropeperm(n - 1024);
        if (n < 1664) return 512 + ropeperm(n - 1536);
        if (n < 1792) return 640 + (n - 1664);
        if (n < 2304) return 1280 + (n - 1792);
        if (n < 2816) return 1792 + (n - 2304);
        if (n < 3328) return 2816 + ropeperm(n - 2816);
        return 3328 + (n - 3328);
    }
    { const int pn = n >> 8, half = (n >> 7) & 1, c = 128 * pn + (n & 127); return half ? DFF + c : c; }
}
template <int MAP> __device__ __forceinline__ void transpose_job(const float* W, int ldw, int coloff, int K, int NP, bf16_t* WT, LAS float* scr, int& base, int gw, int NGW, int lane) {
    const int nblk = NP / 32, items = (K / 64) * nblk;
    int start = (gw - base) % NGW; if (start < 0) start += NGW;
    for (int it = start; it < items; it += NGW) {
        const int kb = it / nblk, nb = it % nblk, k0 = 64 * kb, n0 = 32 * nb;
        const int sc = coloff + map_col<MAP>(n0 + (lane & 31));
#pragma unroll 8
        for (int i = 0; i < 32; ++i) { const int kk = 2 * i + (lane >> 5); scr[kk * 33 + (lane & 31)] = W[(size_t)(k0 + kk) * ldw + sc]; }
        asm volatile("s_waitcnt lgkmcnt(0)" ::: "memory");
        const int c = lane & 7;
#pragma unroll
        for (int j = 0; j < 4; ++j) { const int n = (lane >> 3) + 8 * j; const LAS float* s = scr + (8 * c) * 33 + n;
            u32x4 o; o.x = cvtpk(s[0 * 33], s[1 * 33]); o.y = cvtpk(s[2 * 33], s[3 * 33]); o.z = cvtpk(s[4 * 33], s[5 * 33]); o.w = cvtpk(s[6 * 33], s[7 * 33]);
            *(u32x4*)(WT + (size_t)(n0 + n) * K + k0 + 8 * c) = o; }
        asm volatile("s_waitcnt lgkmcnt(0)" ::: "memory");
    }
    base = (base + items) % NGW;
}

__device__ __forceinline__ void xg_phase(const float* x, const float* g, bf16_t* XG, float* rss, int gw, int NGW, int lane) {
    asm volatile("" : "+v"(lane));
    for (int m = gw; m < TOK; m += NGW) {
        const f32x4* xr = (const f32x4*)(x + (size_t)m * DM) + lane; const f32x4* gr = (const f32x4*)g + lane; float s = 0.f;
#pragma unroll
        for (int j = 0; j < 4; ++j) { const f32x4 v = xr[64 * j]; s += (v.x * v.x + v.y * v.y) + (v.z * v.z + v.w * v.w); const f32x4 y = v * gr[64 * j];
            u32x2 w; w.x = cvtpk(y.x, y.y); w.y = cvtpk(y.z, y.w); ((u32x2*)(XG + (size_t)m * DM))[lane + 64 * j] = w; }
        s = wave_sum(s); if (lane == 0) rss[m] = s;
    }
}
__device__ __forceinline__ void final_phase(float* x, const float* g, const float* rss, int gw, int NGW, int lane) {
    asm volatile("" : "+v"(lane));
    for (int m = gw; m < TOK; m += NGW) { const float rsv = rs_of(rss[m]); f32x4* xr = (f32x4*)(x + (size_t)m * DM) + lane; const f32x4* gr = (const f32x4*)g + lane;
#pragma unroll
        for (int j = 0; j < 4; ++j) xr[64 * j] = xr[64 * j] * rsv * gr[64 * j]; }
}
constexpr int LDS_BYTES = 147456;
constexpr int NPH = 18;
#ifndef PHMASK
#define PHMASK 0xFFFF
#endif
#define KEN(n) (((PHMASK) >> (n)) & 1)
struct Args { const float* in[13]; float* out; unsigned char* ws; int ph_lo, ph_hi; };
static_assert(sizeof(Args) == 13 * 8 + 8 + 8 + 8, "Args has no padding");

__global__ void __launch_bounds__(NTHREADS, 2) fwd_kernel(Args a) {
    extern __shared__ __attribute__((aligned(16))) unsigned char lds_raw[];
    LAS unsigned char* lds = (LAS unsigned char*)lds_raw;
    const int tid = threadIdx.x, wave = __builtin_amdgcn_readfirstlane(tid >> 6);
#define LANE_OPAQUE() ({ int t_ = threadIdx.x; asm volatile("" : "+v"(t_)); t_ & 63; })
    const int G = gridDim.x, bx = blockIdx.x;
    const int gw = bx * NWAVES + wave, NGW = G * NWAVES, NGT = G * NTHREADS;
    unsigned char* ws = a.ws;
    const float* x_in = a.in[0]; float* xo = a.out;
    bf16_t* Hb = (bf16_t*)(ws + WS_H); bf16_t* Qb = (bf16_t*)(ws + WS_Q); bf16_t* Gb = (bf16_t*)(ws + WS_G); bf16_t* Kb = (bf16_t*)(ws + WS_K); bf16_t* VTb = (bf16_t*)(ws + WS_VT);
    float* ropeC = (float*)(ws + WS_ROPE); float* ropeS = ropeC + SEQ * 32; float* KPb = (float*)(ws + WS_KP);
    unsigned* ctl = (unsigned*)(ws + WS_CTL); float* RS = (float*)(ws + WS_RS);
    const int lo = a.ph_lo, hi = a.ph_hi;
#define RUN(k) (lo <= (k) && (k) < hi)
#if MK_ONE_LAUNCH
    volatile LAS unsigned* MISC = (volatile LAS unsigned*)(lds + 131072 + 320);
    if (tid < 32) MISC[tid] = 0u;
    __syncthreads();
    XcdBarrier bar = xcd_barrier_post(ctl + 4096, MISC + 8);
#define SEAM(k) do { if (RUN(k) && RUN((k) + 1)) { if ((k) == 0) cg::this_grid().sync(); else xcd_barrier(bar); } } while (0)
#else
#define SEAM(k) do { } while (0)
#endif

#ifdef DBL_P0
    for (int rep_ = 0; rep_ < 2; ++rep_)
#endif
    if (KEN(0) && RUN(0)) {
        LAS float* scr = (LAS float*)(lds + wave * 16384);
        int base = 0; const int lane = LANE_OPAQUE(); const int gtid = bx * NTHREADS + wave * 64 + lane;
        for (int l = 0; l < 2; ++l) {
            unsigned char* wb = ws + WS_WB + (size_t)l * WB_LAYER;
            const float* w_in = a.in[2] + (size_t)l * DM * D_IN;
            transpose_job<1>(w_in, D_IN, 0, DM, NQKV, (bf16_t*)(wb + WB_IN), scr, base, gw, NGW, lane);
            transpose_job<0>(w_in, D_IN, NQKV, DM, NGATE, (bf16_t*)(wb + WB_G), scr, base, gw, NGW, lane);
            for (int i = 0; i < 3; ++i) transpose_job<0>(a.in[5] + (size_t)(l * 3 + i) * 512 * DM, DM, 0, 512, DM, (bf16_t*)(wb + WB_BR + (size_t)i * DM * 512 * 2), scr, base, gw, NGW, lane);
            transpose_job<0>(a.in[6] + (size_t)l * DM * DM, DM, 0, DM, DM, (bf16_t*)(wb + WB_O), scr, base, gw, NGW, lane);
            transpose_job<2>(a.in[8] + (size_t)l * DM * 2 * DFF, 2 * DFF, 0, DM, 2 * DFF, (bf16_t*)(wb + WB_U), scr, base, gw, NGW, lane);
            transpose_job<0>(a.in[11] + (size_t)l * DFF * DM, DM, 0, DFF, DM, (bf16_t*)(wb + WB_D), scr, base, gw, NGW, lane);
        }
        for (int i = gtid; i < SEQ * 32; i += NGT) {
            const int t = i >> 5, f = i & 31;
            const float inv = exp2f(-(float)f * (13.287712379549449f / 32.0f));
            const float ang = (float)t * inv;
            const double rev = (double)ang * 0.15915494309189535; const float fr = (float)(rev - rint(rev));
            ropeC[i] = __builtin_amdgcn_cosf(fr); ropeS[i] = __builtin_amdgcn_sinf(fr);
        }
        xg_phase(x_in, a.in[1], Hb, RS, gw, NGW, lane);
        __syncthreads();
    }
    SEAM(0);
    for (int l = 0; l < 2; ++l) {
        const int pb = 1 + 8 * l;
        unsigned char* wb = ws + WS_WB + (size_t)l * WB_LAYER;
#ifdef DBL_PA
        for (int rep_ = 0; rep_ < 2; ++rep_)
#endif
        if (KEN(1) && RUN(pb + 0)) {
            pg8::Gemm g{Hb, (const bf16_t*)(wb + WB_IN), TOK, NQKV, DM, DM}; pg8::StaticOrder S; S.init(TOK, NQKV, G, bx);
            pg8::EpiInproj E{Qb, Kb, VTb, KPb, ropeC, ropeS, RS + (size_t)(2 * l) * TOK};
            pg8::gemm_phase<pg8::EpiInproj, pg8::StaticOrder, true, true>(lds, g, S, E);
        }
        SEAM(pb + 0);
        if (KEN(2) && RUN(pb + 1)) {
#ifdef DBL_ATT
            att::attn_phase(lds, Qb, Kb, VTb, KPb, a.in[4] + l * 8, ctl + 64 * (l + 2), true);
#endif
            att::attn_phase(lds, Qb, Kb, VTb, KPb, a.in[4] + l * 8, ctl + 64 * l); }
        SEAM(pb + 1);
        if (KEN(3) && RUN(pb + 2)) {
            pg8::Gemm g{Hb, (const bf16_t*)(wb + WB_G), TOK, NGATE, DM, DM}; pg8::StaticOrder S; S.init(TOK, NGATE, G, bx);
            pg8::EpiRowBf16<2> E{Gb, NGATE, a.in[3] + (size_t)l * NGATE, RS + (size_t)(2 * l) * TOK};
            pg8::gemm_phase<pg8::EpiRowBf16<2>, pg8::StaticOrder, true, true>(lds, g, S, E);
        }
        SEAM(pb + 2);
        if (KEN(4) && RUN(pb + 3)) {
            int first = 1;
            for (int i = 0; i < 3; ++i) {
#ifdef SKIPBR
                if (i == SKIPBR) continue;
#endif
                pg8::Gemm g{Qb + 512 * i, (const bf16_t*)(wb + WB_BR + (size_t)i * DM * 512 * 2), TOK, DM, 512, QPITCH}; pg8::StaticOrder S; S.init(TOK, DM, G, bx);
                pg8::EpiBranch E{Hb, Gb, 1024 * i, first ? 0 : 1}; first = 0;
                pg8::gemm_phase<pg8::EpiBranch, pg8::StaticOrder, true, true>(lds, g, S, E);
            }
        }
        SEAM(pb + 3);
        if (KEN(5) && RUN(pb + 4)) {
            pg8::Gemm g{Hb, (const bf16_t*)(wb + WB_O), TOK, DM, DM, DM}; pg8::StaticOrder S; S.init(TOK, DM, G, bx);
            pg8::EpiResidualNorm E{l == 0 ? x_in : (const float*)xo, xo, Qb, a.in[7] + (size_t)l * DM, RS + (size_t)(2 * l + 1) * TOK, (bf16_t*)(ws + WS_AH)};
            pg8::gemm_phase<pg8::EpiResidualNorm, pg8::StaticOrder, true, true>(lds, g, S, E);
        }
        SEAM(pb + 4);
        if (KEN(7) && RUN(pb + 5)) {
            pg8::Gemm g{(const bf16_t*)(ws + WS_AH), (const bf16_t*)(wb + WB_U), 256, 2 * DFF, DM, DM}; pg8::StaticOrder S; S.init(256, 2 * DFF, G, bx);
            pg8::EpiHalo E{(float*)(ws + WS_UH), RS + (size_t)(2 * l + 1) * TOK};
            pg8::gemm_phase<pg8::EpiHalo, pg8::StaticOrder, true, true>(lds, g, S, E);
        }
        SEAM(pb + 5);
#ifdef DBL_PG
        for (int rep_ = 0; rep_ < 2; ++rep_)
#endif
        if (KEN(8) && RUN(pb + 6)) {
            pg8::Gemm g{Qb, (const bf16_t*)(wb + WB_U), TOK, 2 * DFF, DM, DM}; pg8::StaticOrder S; S.init(TOK, 2 * DFF, G, bx);
            pg8::EpiUpConv E{Gb, (const float*)(ws + WS_UH), a.in[9] + (size_t)l * 3 * 2 * DFF, a.in[10] + (size_t)l * 2 * DFF, (LAS float*)(lds + 131072 + 1024), RS + (size_t)(2 * l + 1) * TOK};
            pg8::gemm_phase<pg8::EpiUpConv, pg8::StaticOrder, true, true>(lds, g, S, E);
        }
        SEAM(pb + 6);
        if (KEN(9) && RUN(pb + 7)) {
            pg8::Gemm g{Gb, (const bf16_t*)(wb + WB_D), TOK, DM, DFF, DFF}; pg8::StaticOrder S; S.init(TOK, DM, G, bx);
            pg8::EpiResidualNorm E{xo, xo, l == 0 ? Hb : (bf16_t*)nullptr, l == 0 ? a.in[1] + DM : (const float*)nullptr, RS + (size_t)(l == 0 ? 2 : 4) * TOK, (bf16_t*)nullptr};
            pg8::gemm_phase<pg8::EpiResidualNorm, pg8::StaticOrder, true, true>(lds, g, S, E);
        }
        SEAM(pb + 7);
    }
    if (KEN(10) && RUN(17)) { final_phase(xo, a.in[12], RS + (size_t)4 * TOK, gw, NGW, LANE_OPAQUE()); }
#undef RUN
#undef SEAM
}

extern "C" void kernel_launch(void* const* d_in, const int* in_sizes, int n_in, void* d_out, int out_size, void* d_ws, size_t ws_size, hipStream_t stream) {
    static int grid = 0;
    if (grid == 0) {
        if (n_in != 13 || in_sizes[0] != TOK * DM || out_size != TOK * DM || ws_size < WS_END) { fprintf(stderr, "kernel_launch: unexpected shapes / workspace (n_in %d, ws %zu)\n", n_in, ws_size); grid = -1; return; }
        int dev = 0, cus = 0, per_cu = 0;
        hipGetDevice(&dev); hipDeviceGetAttribute(&cus, hipDeviceAttributeMultiprocessorCount, dev);
        if (hipFuncSetAttribute((const void*)fwd_kernel, hipFuncAttributeMaxDynamicSharedMemorySize, LDS_BYTES) != hipSuccess) { fprintf(stderr, "kernel_launch: hipFuncSetAttribute failed\n"); grid = -1; return; }
        if (hipOccupancyMaxActiveBlocksPerMultiprocessor(&per_cu, (const void*)fwd_kernel, NTHREADS, LDS_BYTES) != hipSuccess || per_cu < 1) { fprintf(stderr, "kernel_launch: occupancy query gave %d\n", per_cu); per_cu = 1; }
        (void)hipGetLastError();
        grid = cus * per_cu;
    }
    if (grid < 0) return;
    hipMemsetAsync((char*)d_ws + WS_CTL, 0, CTL_BYTES, stream);
    hipMemsetAsync((char*)d_ws + WS_RS + (size_t)TOK * 4, 0, (size_t)4 * TOK * 4, stream);
    Args a{};
    for (int i = 0; i < 13; ++i) a.in[i] = (const float*)d_in[i];
    a.out = (float*)d_out; a.ws = (unsigned char*)d_ws;
#if MK_ONE_LAUNCH
    a.ph_lo = 0; a.ph_hi = NPH;
    void* args[] = {&a};
    hipError_t e = hipLaunchCooperativeKernel((const void*)fwd_kernel, dim3(grid), dim3(NTHREADS), args, LDS_BYTES, stream);
    if (e != hipSuccess) fprintf(stderr, "cooperative launch failed: %s (grid %d)\n", hipGetErrorString(e), grid);
#else
    for (int p = 0; p < NPH; ++p) { a.ph_lo = p; a.ph_hi = p + 1; hipLaunchKernelGGL(fwd_kernel, dim3(grid), dim3(NTHREADS), LDS_BYTES, stream, a); }
#endif
}
```

```cpp
#include <hip/hip_runtime.h>
#include <hip/hip_cooperative_groups.h>
#include <cstdio>
#include <cstdint>
namespace cg = cooperative_groups;
namespace pg8 {
#define PG8_LAS __attribute__((address_space(3)))
typedef unsigned short bf16_t;
typedef short bf16x8 __attribute__((ext_vector_type(8)));
typedef float f32x4 __attribute__((ext_vector_type(4)));
typedef unsigned u32x4 __attribute__((ext_vector_type(4)));
constexpr int BM = 256, BK = 64, HALF = 128, HTB = HALF * BK * 2  , STAGE_BYTES = 8 * HTB, NXCD = 8, WGM = 8;

__host__ __device__ __forceinline__ int lds_byte(int r, int c) { const int st = (r >> 4) * 2 + (c >> 5), rr = r & 15, cc = c & 31, ob = rr * 64 + cc * 2; return st * 1024 + (ob ^ (((ob >> 9) & 1) << 5)); }
__host__ __device__ __forceinline__ void stage_rc(int b, int& R, int& C) { const int st = b / 1024, sb = b % 1024, swz = sb ^ (((sb >> 9) & 1) << 5); R = (st >> 1) * 16 + swz / 64; C = (st & 1) * 32 + (swz % 64) / 2; }
__host__ __device__ __forceinline__ int perm32(int rho) { const int n = rho >> 4, i = rho & 15; return 8 * (i >> 2) + 4 * n + (i & 3); }

struct Unit { int pm, pn; };
struct Gemm { const bf16_t* A; const bf16_t* Bt; int M, N, K, lda; };

struct StaticOrder {
    int nM, nN, nwg, G, c;
    __host__ __device__ void init(int M, int N, int G_, int c_) { nM = M / BM; nN = N / BM; nwg = nM * nN; G = G_; c = c_; }
    __host__ __device__ bool next(int i, Unit& u) const {
        const long L = (long)i * G + c; if (L >= nwg) return false;
        int wgid = (int)L; { const int q = nwg / NXCD, r = nwg % NXCD, xcd = wgid % NXCD, off = wgid / NXCD; wgid = (xcd < r ? xcd * (q + 1) : r * (q + 1) + (xcd - r) * q) + off; }
        const int nig = WGM * nN, gid = wgid / nig, fm = gid * WGM, gsz = (nM - fm) < WGM ? (nM - fm) : WGM;
        u.pm = fm + ((wgid % nig) % gsz); u.pn = (wgid % nig) / gsz; return true;
    }
    __device__ __forceinline__ void a_ready(const Unit&) const {}
    __device__ __forceinline__ void done(const Unit&) const {}
};

__device__ __forceinline__ unsigned cvt_pk_bf16(float lo, float hi) { unsigned r; asm volatile("v_cvt_pk_bf16_f32 %0, %1, %2" : "=v"(r) : "v"(lo), "v"(hi)); return r; }
typedef float f32x2 __attribute__((ext_vector_type(2)));
template <class Epi, class Sched, bool ALIGN_EPI = false, bool SP2 = false>
__device__ __forceinline__ void gemm_phase(PG8_LAS unsigned char* lds, const Gemm g, const Sched& S, const Epi& E) {
    int tid_ = threadIdx.x; asm volatile("" : "+v"(tid_));
    const int tid = tid_, wid = __builtin_amdgcn_readfirstlane(tid >> 6), lane = tid & 63, wr = wid >> 2, wc = wid & 3, fr = lane & 15, fq = lane >> 4;
    const int K = g.K, nt = K / BK;
    unsigned voffA[2], voffB[2];
#pragma unroll
    for (int i = 0; i < 2; ++i) { int R, C; stage_rc(tid * 16 + i * 8192, R, C); const int Rb = Epi::PERM ? ((R & ~31) + perm32(R & 31)) : R;
        voffA[i] = (unsigned)(R * g.lda + C) * 2u; voffB[i] = (unsigned)(Rb * K + C) * 2u; }
    const size_t kstep = (size_t)(BK * 2);
    const size_t hstep = (size_t)HALF * K * 2;
    const size_t tstep = 2 * hstep; const size_t hstepA = (size_t)HALF * g.lda * 2, tstepA = 2 * hstepA;
    const unsigned ldsw = (unsigned)wid * 1024u;
    const int aoff = lds_byte(wr * 64 + fr, fq * 8), boff = lds_byte(wc * 32 + fr, fq * 8);
#define PG8_SA(b, h) (((b) * 2 + (h)) * HTB)
#define PG8_SB(b, h) ((4 + (b) * 2 + (h)) * HTB)
#define PG8_STAGE(bufoff, gbase, voff) do { _Pragma("unroll") for (int _i = 0; _i < 2; ++_i) \
        __builtin_amdgcn_global_load_lds((const unsigned*)((const char*)(gbase) + (voff)[_i]), (PG8_LAS unsigned*)(lds + (bufoff) + ldsw + _i * 8192), 16, 0, 0); } while (0)
#define PG8_LDA(dst, b, h) do { _Pragma("unroll") for (int m = 0; m < 4; ++m) _Pragma("unroll") for (int k = 0; k < 2; ++k) dst[m][k] = *(const PG8_LAS bf16x8*)(lds + PG8_SA(b, h) + aoff + m * 2048 + k * 1024); } while (0)
#define PG8_LDB(dst, b, h) do { _Pragma("unroll") for (int n = 0; n < 2; ++n) _Pragma("unroll") for (int k = 0; k < 2; ++k) dst[n][k] = *(const PG8_LAS bf16x8*)(lds + PG8_SB(b, h) + boff + n * 2048 + k * 1024); } while (0)
#define PG8_MMA(ai, bj, At, Bt) do { __builtin_amdgcn_s_setprio(1); _Pragma("unroll") for (int m = 0; m < 4; ++m) _Pragma("unroll") for (int n = 0; n < 2; ++n) _Pragma("unroll") for (int k = 0; k < 2; ++k) \
        acc[ai][bj][m][n] = __builtin_amdgcn_mfma_f32_16x16x32_bf16(Bt[n][k], At[m][k], acc[ai][bj][m][n], 0, 0, 0); __builtin_amdgcn_s_setprio(0); } while (0)
#define PG8_WAIT_V(n) asm volatile("s_waitcnt vmcnt(" #n ")" ::: "memory")
#define PG8_WAIT_L(n) asm volatile("s_waitcnt lgkmcnt(" #n ")" ::: "memory")
#define PG8_BAR __builtin_amdgcn_s_barrier()
#define PG8_SCHED __builtin_amdgcn_sched_barrier(0)
    Unit cur, nxt; int ui = 0;
    if (!S.next(0, cur)) return;
    f32x4 acc[2][2][4][2];
#pragma unroll
    for (int a = 0; a < 2; ++a)
#pragma unroll
        for (int b = 0; b < 2; ++b)
#pragma unroll
            for (int m = 0; m < 4; ++m)
#pragma unroll
                for (int n = 0; n < 2; ++n) acc[a][b][m][n] = (f32x4){0.f, 0.f, 0.f, 0.f};
    bf16x8 At[4][2], B0[2][2], B1[2][2];
    const char* cA = (const char*)g.A + (size_t)cur.pm * tstepA; const char* cB = (const char*)g.Bt + (size_t)cur.pn * tstep;
    S.a_ready(cur);
    if constexpr (SP2) {
        PG8_STAGE(PG8_SB(0, 0), cB, voffB); PG8_STAGE(PG8_SB(0, 1), cB + hstep, voffB); PG8_STAGE(PG8_SA(0, 0), cA, voffA); PG8_STAGE(PG8_SA(0, 1), cA + hstepA, voffA);
        if (wr == 1) PG8_BAR;
        PG8_WAIT_V(2); PG8_BAR;
        PG8_STAGE(PG8_SB(1, 0), cB + kstep, voffB); PG8_STAGE(PG8_SA(1, 0), cA + kstep, voffA); PG8_STAGE(PG8_SB(1, 1), cB + hstep + kstep, voffB);
        PG8_WAIT_V(6); PG8_BAR;
    } else {
        PG8_STAGE(PG8_SB(0, 0), cB, voffB); PG8_STAGE(PG8_SA(0, 0), cA, voffA); PG8_STAGE(PG8_SB(0, 1), cB + hstep, voffB); PG8_STAGE(PG8_SA(0, 1), cA + hstepA, voffA);
        if (wr == 1) PG8_BAR;
        PG8_WAIT_V(4); PG8_BAR;
        PG8_STAGE(PG8_SB(1, 0), cB + kstep, voffB); PG8_STAGE(PG8_SA(1, 0), cA + kstep, voffA); PG8_STAGE(PG8_SB(1, 1), cB + hstep + kstep, voffB);
        PG8_WAIT_V(6); PG8_BAR;
    }
    for (;;) {
        const bool has_next = S.next(ui + 1, nxt);
        const char* nA = has_next ? (const char*)g.A + (size_t)nxt.pm * tstepA : cA; const char* nB = has_next ? (const char*)g.Bt + (size_t)nxt.pn * tstep : cB;
        for (int t = 0; t < nt; t += 2) {
            const bool last = (t == nt - 2);
            const char* a1 = cA + (size_t)(t + 1) * kstep;
            const char* a2 = last ? nA : cA + (size_t)(t + 2) * kstep; const char* b2 = last ? nB : cB + (size_t)(t + 2) * kstep;
            const char* a3 = a2 + kstep; const char* b3 = b2 + kstep;
            if (last && has_next) S.a_ready(nxt);
            if constexpr (SP2) {
            PG8_LDB(B0, 0, 0); PG8_LDB(B1, 0, 1); PG8_SCHED; PG8_LDA(At, 0, 0); PG8_STAGE(PG8_SA(1, 1), a1 + hstepA, voffA);
            PG8_WAIT_V(8); PG8_WAIT_L(0); PG8_BAR; PG8_MMA(0, 0, At, B0); PG8_MMA(0, 1, At, B1); PG8_BAR; PG8_SCHED;
            PG8_LDA(At, 0, 1); PG8_STAGE(PG8_SB(0, 0), b2, voffB); PG8_STAGE(PG8_SB(0, 1), b2 + hstep, voffB); PG8_STAGE(PG8_SA(0, 0), a2, voffA);
            PG8_WAIT_V(8); PG8_WAIT_L(0); PG8_BAR; PG8_MMA(1, 0, At, B0); PG8_MMA(1, 1, At, B1); PG8_BAR; PG8_SCHED;
            PG8_LDB(B0, 1, 0); PG8_LDB(B1, 1, 1); PG8_SCHED; PG8_LDA(At, 1, 0); PG8_STAGE(PG8_SA(0, 1), a2 + hstepA, voffA);
            PG8_WAIT_V(8); PG8_WAIT_L(0); PG8_BAR; PG8_MMA(0, 0, At, B0); PG8_MMA(0, 1, At, B1); PG8_BAR; PG8_SCHED;
            PG8_LDA(At, 1, 1); PG8_STAGE(PG8_SB(1, 0), b3, voffB); PG8_STAGE(PG8_SB(1, 1), b3 + hstep, voffB); PG8_STAGE(PG8_SA(1, 0), a3, voffA);
            PG8_WAIT_V(8); PG8_WAIT_L(0); PG8_BAR; PG8_MMA(1, 0, At, B0); PG8_MMA(1, 1, At, B1); PG8_BAR; PG8_SCHED;
            } else {
            PG8_LDB(B0, 0, 0); PG8_SCHED; PG8_LDA(At, 0, 0); PG8_STAGE(PG8_SA(1, 1), a1 + hstepA, voffA);
            PG8_WAIT_L(8); PG8_BAR; PG8_WAIT_L(0); PG8_MMA(0, 0, At, B0); PG8_BAR; PG8_SCHED;
            PG8_LDB(B1, 0, 1); PG8_STAGE(PG8_SB(0, 0), b2, voffB);
            PG8_BAR; PG8_WAIT_L(0); PG8_MMA(0, 1, At, B1); PG8_BAR;
            PG8_LDA(At, 0, 1); PG8_STAGE(PG8_SA(0, 0), a2, voffA);
            PG8_BAR; PG8_WAIT_L(0); PG8_MMA(1, 0, At, B0); PG8_BAR; PG8_SCHED;
            PG8_STAGE(PG8_SB(0, 1), b2 + hstep, voffB);
            PG8_WAIT_V(6); PG8_BAR; PG8_MMA(1, 1, At, B1); PG8_BAR;
            PG8_LDB(B0, 1, 0); PG8_SCHED; PG8_LDA(At, 1, 0); PG8_STAGE(PG8_SA(0, 1), a2 + hstepA, voffA);
            PG8_WAIT_L(8); PG8_BAR; PG8_WAIT_L(0); PG8_MMA(0, 0, At, B0); PG8_BAR; PG8_SCHED;
            PG8_LDB(B1, 1, 1); PG8_STAGE(PG8_SB(1, 0), b3, voffB);
            PG8_BAR; PG8_WAIT_L(0); PG8_MMA(0, 1, At, B1); PG8_BAR;
            PG8_LDA(At, 1, 1); PG8_STAGE(PG8_SA(1, 0), a3, voffA);
            PG8_BAR; PG8_WAIT_L(0); PG8_MMA(1, 0, At, B0); PG8_BAR; PG8_SCHED;
            PG8_STAGE(PG8_SB(1, 1), b3 + hstep, voffB);
            PG8_WAIT_V(6); PG8_BAR; PG8_MMA(1, 1, At, B1); PG8_BAR;
            }
        }
        if constexpr (ALIGN_EPI) { if (wr == 0) PG8_BAR; }
        if constexpr (!Epi::AFTER_DRAIN) { E(acc, cur, wr, wc, fr, fq); S.done(cur); }
        if (!has_next) break;
#pragma unroll
        for (int a = 0; a < 2; ++a)
#pragma unroll
            for (int b = 0; b < 2; ++b)
#pragma unroll
                for (int m = 0; m < 4; ++m)
#pragma unroll
                    for (int n = 0; n < 2; ++n) acc[a][b][m][n] = (f32x4){0.f, 0.f, 0.f, 0.f};
        cur = nxt; cA = nA; cB = nB; ++ui;
        if constexpr (ALIGN_EPI) { if (wr == 1) PG8_BAR; }
    }
    PG8_WAIT_V(0);
    if constexpr (!ALIGN_EPI) { if (wr == 0) PG8_BAR; }
    PG8_BAR;
    if constexpr (Epi::AFTER_DRAIN) { E.fused(acc, cur, wr, wc, fr, fq, lds, wid, lane); S.done(cur); }
#undef PG8_SA
#undef PG8_SB
#undef PG8_STAGE
#undef PG8_LDA
#undef PG8_LDB
#undef PG8_MMA
#undef PG8_WAIT_V
#undef PG8_WAIT_L
#undef PG8_BAR
#undef PG8_SCHED
}
}

#ifndef MK_ONE_LAUNCH
#define MK_ONE_LAUNCH 1
#endif
#define LAS __attribute__((address_space(3)))
typedef unsigned short bf16_t;
typedef short bf16x8 __attribute__((ext_vector_type(8)));
typedef short s16x4 __attribute__((ext_vector_type(4)));
typedef float f32x4 __attribute__((ext_vector_type(4)));
typedef unsigned u32x4 __attribute__((ext_vector_type(4)));
typedef unsigned u32x2 __attribute__((ext_vector_type(2)));

constexpr int BATCH = 8, SEQ = 2048, DM = 1024, TOK = BATCH * SEQ;
constexpr int D_IN = 6912, NQKV = 3840, NGATE = 3072, QPITCH = 1536, KPITCH = 1152, NVH = 18;
constexpr int DFF = 2816, CW0 = 1536, CW1 = 1280;
constexpr float RMS_EPS = 1e-6f;
constexpr float LOG2E = 1.4426950408889634f;
constexpr float QSCALE = 0.125f * LOG2E;
constexpr int NWAVES = 8, NTHREADS = 512;
constexpr size_t MiB = 1u << 20;
constexpr size_t WS_CTL = 0, CTL_BYTES = 32768;
constexpr size_t WS_ROPE = 1 * MiB;
constexpr size_t WS_KP = 1 * MiB + 512 * 1024;
constexpr size_t WS_WB = 2 * MiB, WB_LAYER = 35 * MiB;
constexpr size_t WB_IN = 0, WB_G = WB_IN + (size_t)NQKV * DM * 2, WB_BR = WB_G + (size_t)NGATE * DM * 2, WB_O = WB_BR + (size_t)3 * DM * 512 * 2,
                 WB_U = WB_O + (size_t)DM * DM * 2, WB_D = WB_U + (size_t)2 * DFF * DM * 2, WB_END = WB_D + (size_t)DM * DFF * 2;
static_assert(WB_END == WB_LAYER, "weight map");
constexpr size_t WS_H = 72 * MiB;
constexpr size_t WS_Q = 104 * MiB;
constexpr size_t WS_G = 152 * MiB;
constexpr size_t WS_K = 152 * MiB;
constexpr size_t WS_VT = 188 * MiB;
constexpr size_t WS_VC = 224 * MiB;
constexpr size_t WS_AH = 248 * MiB;
constexpr size_t WS_UH = 249 * MiB;
constexpr size_t WS_RS = 252 * MiB;
constexpr size_t RS_BYTES = (size_t)5 * TOK * 4;
constexpr size_t WS_END = 254 * MiB;
__device__ __forceinline__ float rs_of(float ss) { return __builtin_amdgcn_rsqf(ss * (1.f / DM) + RMS_EPS); }

__device__ __forceinline__ float bf2f(unsigned short b) { return __uint_as_float((unsigned)b << 16); }
__device__ __forceinline__ unsigned cvtpk(float lo, float hi) { return pg8::cvt_pk_bf16(lo, hi); }
__device__ __forceinline__ float fast_exp2(float x) { return __builtin_amdgcn_exp2f(x); }
__device__ __forceinline__ float fast_log2(float x) { return __builtin_amdgcn_logf(x); }
__device__ __forceinline__ float fast_rcp(float x) { return __builtin_amdgcn_rcpf(x); }

namespace pg8 {
struct EpiInproj {
    static constexpr bool PERM = false, AFTER_DRAIN = false;
    bf16_t* Q; bf16_t* Kb; bf16_t* VT; float* KP; const float* ropeC; const float* ropeS; const float* rss; bf16_t* VC;
    __device__ __forceinline__ void operator()(const f32x4 (&acc)[2][2][4][2], const Unit& u, int wr, int wc, int fr, int fq) const {
        const int rbase = u.pm * BM + wr * 64 + fr;
#pragma unroll
        for (int bj = 0; bj < 2; ++bj) {
            const int gc0 = u.pn * BM + bj * HALF + wc * 32;
            int kind, dcol, pitch; bf16_t* dst; float sc = 1.f; int vh = 0; bool kp = false;
            if (gc0 < 1536) { dst = Q; pitch = QPITCH; dcol = gc0; sc = QSCALE; kind = (gc0 >= 512 && gc0 < 1024) ? 1 : 0; }
            else if (gc0 < 1664) { dst = Kb; pitch = KPITCH; dcol = gc0 - 1536; kind = 0; }
            else if (gc0 < 1792) { dst = VT; pitch = 0; dcol = 0; kind = 2; vh = (gc0 - 1664) >> 6; }
            else if (gc0 < 2304) { dst = Kb; pitch = KPITCH; dcol = 128 + (gc0 - 1792); kind = 1; }
            else if (gc0 < 2816) { dst = VT; pitch = 0; dcol = 0; kind = 2; vh = 2 + ((gc0 - 2304) >> 6); }
            else if (gc0 < 3328) { dst = Kb; pitch = KPITCH; dcol = 640 + (gc0 - 2816); kind = 0; kp = true; }
            else { dst = VC; pitch = 512; dcol = gc0 - 3328; kind = 1; }
            if (kind == 0) {
                const int g = (gc0 >> 5) & 1, i0 = 16 * g + 4 * fq, hc = dcol & ~63;
                f32x4 s1 = {0.f, 0.f, 0.f, 0.f}, s2 = {0.f, 0.f, 0.f, 0.f};
#pragma unroll
                for (int ai = 0; ai < 2; ++ai)
#pragma unroll
                    for (int m = 0; m < 4; ++m) {
                        const int r = rbase + ai * HALF + m * 16, t = r & (SEQ - 1);
                        const f32x4 c4 = *(const f32x4*)(ropeC + t * 32 + i0), s4 = *(const f32x4*)(ropeS + t * 32 + i0);
                        const float rsv = rs_of(rss[r]);
                        const f32x4 x1 = acc[ai][bj][m][0] * rsv, x2 = acc[ai][bj][m][1] * rsv;
                        f32x4 o1 = x1 * c4 - x2 * s4, o2 = x2 * c4 + x1 * s4;
                        s1 += o1; s2 += o2;
                        o1 = o1 * sc; o2 = o2 * sc;
                        bf16_t* p = dst + (size_t)r * pitch + hc + i0;
                        u32x2 w1, w2; w1.x = cvt_pk_bf16(o1[0], o1[1]); w1.y = cvt_pk_bf16(o1[2], o1[3]); w2.x = cvt_pk_bf16(o2[0], o2[1]); w2.y = cvt_pk_bf16(o2[2], o2[3]);
                        *(u32x2*)p = w1; *(u32x2*)(p + 32) = w2;
                    }
                if (kp) {
#pragma unroll
                    for (int j = 0; j < 4; ++j) {
#pragma unroll
                        for (int o = 1; o < 16; o <<= 1) { s1[j] += __shfl_xor(s1[j], o); s2[j] += __shfl_xor(s2[j], o); }
                    }
                    if (fr == 0) { float* kpp = KP + (size_t)(u.pm * 2 + wr) * 512 + (hc - 640) + i0; *(f32x4*)kpp = s1; *(f32x4*)(kpp + 32) = s2; }
                }
            } else if (kind == 1) {
#pragma unroll
                for (int ai = 0; ai < 2; ++ai)
#pragma unroll
                    for (int m = 0; m < 4; ++m) {
                        const int r = rbase + ai * HALF + m * 16; const float rsv = rs_of(rss[r]) * sc;
#pragma unroll
                        for (int n = 0; n < 2; ++n) { const f32x4 v = acc[ai][bj][m][n] * rsv; u32x2 w; w.x = cvt_pk_bf16(v[0], v[1]); w.y = cvt_pk_bf16(v[2], v[3]);
                            *(u32x2*)(dst + (size_t)r * pitch + dcol + 16 * n + 4 * fq) = w; }
                    }
            } else {
#pragma unroll
                for (int ai = 0; ai < 2; ++ai)
#pragma unroll
                    for (int m = 0; m < 4; ++m) {
                        const int r = rbase + ai * HALF + m * 16, b = r >> 11, t = r & (SEQ - 1); const float rsv = rs_of(rss[r]);
#pragma unroll
                        for (int n = 0; n < 2; ++n) {
                            const int d0 = (gc0 & 32) + 16 * n + 4 * fq;
                            bf16_t* p = dst + ((size_t)(b * NVH + vh) * 64 + d0) * SEQ + t;
                            const f32x4 v = acc[ai][bj][m][n] * rsv;
                            const unsigned w0 = cvt_pk_bf16(v[0], v[1]), w1 = cvt_pk_bf16(v[2], v[3]);
                            p[0] = (bf16_t)(w0 & 0xffffu); p[SEQ] = (bf16_t)(w0 >> 16); p[2 * SEQ] = (bf16_t)(w1 & 0xffffu); p[3 * SEQ] = (bf16_t)(w1 >> 16);
                        }
                    }
            }
        }
    }
};
template <int ACT> struct EpiRowBf16 {
    static constexpr bool PERM = false, AFTER_DRAIN = false;
    bf16_t* O; int ldc; const float* bias; const float* rss;
    __device__ __forceinline__ void operator()(const f32x4 (&acc)[2][2][4][2], const Unit& u, int wr, int wc, int fr, int fq) const {
        const int row0 = u.pm * BM + wr * 64 + fr, col0 = u.pn * BM + wc * 32 + 4 * fq;
        f32x4 bv[2][2];
#pragma unroll
        for (int bj = 0; bj < 2; ++bj)
#pragma unroll
            for (int n = 0; n < 2; ++n) bv[bj][n] = bias ? *(const f32x4*)(bias + col0 + bj * HALF + 16 * n) : (f32x4){0.f, 0.f, 0.f, 0.f};
#pragma unroll
        for (int ai = 0; ai < 2; ++ai)
#pragma unroll
            for (int m = 0; m < 4; ++m) { bf16_t* rowp = O + (size_t)(row0 + ai * HALF + m * 16) * ldc + col0; const float rsv = rs_of(rss[row0 + ai * HALF + m * 16]);
#pragma unroll
                for (int bj = 0; bj < 2; ++bj)
#pragma unroll
                    for (int n = 0; n < 2; ++n) { f32x4 v0 = acc[ai][bj][m][n] * rsv + bv[bj][n];
                        if (ACT == 2) {
#pragma unroll
                            for (int j = 0; j < 4; ++j) v0[j] = __builtin_amdgcn_rcpf(1.f + __builtin_amdgcn_exp2f(-LOG2E * v0[j]));
                        }
                        u32x2 w; w.x = cvt_pk_bf16(v0[0], v0[1]); w.y = cvt_pk_bf16(v0[2], v0[3]);
                        *(u32x2*)(rowp + bj * HALF + 16 * n) = w; } }
    }
};
struct EpiBranch {
    static constexpr bool PERM = false, AFTER_DRAIN = false;
    bf16_t* Mo; const bf16_t* G; int goff; int accum;
    __device__ __forceinline__ void operator()(const f32x4 (&acc)[2][2][4][2], const Unit& u, int wr, int wc, int fr, int fq) const {
        const int row0 = u.pm * BM + wr * 64 + fr, col0 = u.pn * BM + wc * 32 + 4 * fq;
#pragma unroll
        for (int ai = 0; ai < 2; ++ai)
#pragma unroll
            for (int m = 0; m < 4; ++m) { const size_t r = (size_t)(row0 + ai * HALF + m * 16);
#pragma unroll
                for (int bj = 0; bj < 2; ++bj)
#pragma unroll
                    for (int n = 0; n < 2; ++n) {
                        const int c = col0 + bj * HALF + 16 * n;
                        const u32x2 gv = *(const u32x2*)(G + r * NGATE + goff + c);
                        u32x2 mv = {0u, 0u}; if (accum) mv = *(const u32x2*)(Mo + r * DM + c);
                        const f32x4 a0 = acc[ai][bj][m][n];
                        float o[4];
#pragma unroll
                        for (int k = 0; k < 2; ++k) {
                            const unsigned gw = gv[k], mw = mv[k];
                            o[2 * k] = __uint_as_float(mw << 16) + __uint_as_float(gw << 16) * a0[2 * k];
                            o[2 * k + 1] = __uint_as_float(mw & 0xffff0000u) + __uint_as_float(gw & 0xffff0000u) * a0[2 * k + 1];
                        }
                        u32x2 w; w.x = cvt_pk_bf16(o[0], o[1]); w.y = cvt_pk_bf16(o[2], o[3]);
                        *(u32x2*)(Mo + r * DM + c) = w; } }
    }
};
struct EpiResidual {
    static constexpr bool PERM = false, AFTER_DRAIN = false;
    const float* base; float* out;
    __device__ __forceinline__ void operator()(const f32x4 (&acc)[2][2][4][2], const Unit& u, int wr, int wc, int fr, int fq) const {
        const int col0 = u.pn * BM + wc * 32 + 4 * fq;
#pragma unroll
        for (int ai = 0; ai < 2; ++ai)
#pragma unroll
            for (int m = 0; m < 4; ++m) { const size_t off = (size_t)(u.pm * BM + ai * HALF + wr * 64 + m * 16 + fr) * DM + col0;
#pragma unroll
                for (int bj = 0; bj < 2; ++bj)
#pragma unroll
                    for (int n = 0; n < 2; ++n) { const f32x4 bs = *(const f32x4*)(base + off + bj * HALF + n * 16); *(f32x4*)(out + off + bj * HALF + n * 16) = bs + acc[ai][bj][m][n]; } }
    }
};

struct EpiHalo {
    static constexpr bool PERM = false, AFTER_DRAIN = false;
    float* UH; const float* rss;
    __device__ __forceinline__ void operator()(const f32x4 (&acc)[2][2][4][2], const Unit& u, int wr, int wc, int fr, int fq) const {
        const int col0 = u.pn * BM + wc * 32 + 4 * fq;
#pragma unroll
        for (int m = 0; m < 4; ++m) { const int rho = wr * 64 + m * 16 + fr; const size_t off = (size_t)rho * (2 * DFF) + col0;
            int tok = 256 * (rho >> 1) - 2 + (rho & 1); if (tok < 0) tok = 0; const float rsv = rs_of(rss[tok]);
#pragma unroll
            for (int bj = 0; bj < 2; ++bj)
#pragma unroll
                for (int n = 0; n < 2; ++n) *(f32x4*)(UH + off + bj * HALF + n * 16) = acc[0][bj][m][n] * rsv; }
    }
};
struct EpiUpConv {
    static constexpr bool PERM = false, AFTER_DRAIN = false;
    bf16_t* ACT; const float* UH; const float* cw; const float* cb; LAS float* X; const float* rss;
    __device__ __forceinline__ void operator()(const f32x4 (&acc)[2][2][4][2], const Unit& u, int wr, int wc, int fr, int fq) const {
        const int lane = fr + 16 * fq, cl = wc * 32 + 4 * fq;
        const float* rsp = rss + u.pm * BM + wr * 64 + fr;
        if (fr >= 14) {
            float rsr[2][4];
#pragma unroll
            for (int ai = 0; ai < 2; ++ai) rsr[ai][3] = rs_of(rsp[ai * HALF + 48]);
#pragma unroll
            for (int ai = 0; ai < 2; ++ai)
#pragma unroll
                for (int bj = 0; bj < 2; ++bj)
#pragma unroll
                    for (int n = 0; n < 2; ++n) *(LAS f32x4*)(X + ((ai * 2 + wr) * 2 + (fr - 14)) * 256 + bj * HALF + cl + 16 * n) = acc[ai][bj][3][n] * rsr[ai][3];
        }
        asm volatile("s_waitcnt lgkmcnt(0)\n\ts_barrier" ::: "memory");
        const bool seqstart = (u.pm & 7) == 0;
        const int src1 = (lane & 48) | ((fr + 15) & 15), src2 = (lane & 48) | ((fr + 14) & 15);
#pragma unroll
        for (int n = 0; n < 2; ++n) {
            const int ch = u.pn * HALF + cl + 16 * n;
            const f32x4 wa0 = *(const f32x4*)(cw + ch), wa1 = *(const f32x4*)(cw + 2 * DFF + ch), wa2 = *(const f32x4*)(cw + 4 * DFF + ch);
            const f32x4 wv0 = *(const f32x4*)(cw + DFF + ch), wv1 = *(const f32x4*)(cw + 3 * DFF + ch), wv2 = *(const f32x4*)(cw + 5 * DFF + ch);
            const f32x4 ba = *(const f32x4*)(cb + ch), bv = *(const f32x4*)(cb + DFF + ch);
#pragma unroll
            for (int ai = 0; ai < 2; ++ai) {
                const int blk = ai * 2 + wr;
                f32x4 Ba1 = {0.f, 0.f, 0.f, 0.f}, Ba2 = Ba1, Bv1 = Ba1, Bv2 = Ba1;
                if (blk > 0) { const LAS float* xp = X + (blk - 1) * 512 + cl + 16 * n;
                    Ba2 = *(const LAS f32x4*)xp; Ba1 = *(const LAS f32x4*)(xp + 256); Bv2 = *(const LAS f32x4*)(xp + HALF); Bv1 = *(const LAS f32x4*)(xp + 256 + HALF); }
                else if (!seqstart) { const float* hp = UH + (size_t)(2 * u.pm) * (2 * DFF) + u.pn * BM + cl + 16 * n;
                    Ba2 = *(const f32x4*)hp; Ba1 = *(const f32x4*)(hp + 2 * DFF); Bv2 = *(const f32x4*)(hp + HALF); Bv1 = *(const f32x4*)(hp + 2 * DFF + HALF); }
                f32x4 pa1 = Ba1, pa2 = (fr == 0) ? Ba2 : Ba1, pv1 = Bv1, pv2 = (fr == 0) ? Bv2 : Bv1;
#pragma unroll
                for (int m = 0; m < 4; ++m) {
                    const float rsv = rs_of(rsp[ai * HALF + m * 16]);
                    f32x4 ca;
                    { const f32x4 ca0 = acc[ai][0][m][n] * rsv; f32x4 sa1, sa2;
#pragma unroll
                      for (int j = 0; j < 4; ++j) { sa1[j] = __shfl(ca0[j], src1); sa2[j] = __shfl(ca0[j], src2); }
                      const f32x4 a1 = (fr >= 1) ? sa1 : pa1, a2 = (fr >= 2) ? sa2 : pa2;
                      ca = ba + wa0 * a2 + wa1 * a1 + wa2 * ca0; pa1 = sa1; pa2 = sa2;
#pragma unroll
                      for (int j = 0; j < 4; ++j) ca[j] = ca[j] * __builtin_amdgcn_rcpf(1.f + __builtin_amdgcn_exp2f(-LOG2E * ca[j])); }

                    { const f32x4 cv0 = acc[ai][1][m][n] * rsv; f32x4 sv1, sv2;
#pragma unroll
                      for (int j = 0; j < 4; ++j) { sv1[j] = __shfl(cv0[j], src1); sv2[j] = __shfl(cv0[j], src2); }
                      const f32x4 v1 = (fr >= 1) ? sv1 : pv1, v2 = (fr >= 2) ? sv2 : pv2;
                      const f32x4 cv = bv + wv0 * v2 + wv1 * v1 + wv2 * cv0; pv1 = sv1; pv2 = sv2;
                      const f32x4 o = ca * cv;
                      u32x2 w; w.x = cvt_pk_bf16(o[0], o[1]); w.y = cvt_pk_bf16(o[2], o[3]);
                      *(u32x2*)(ACT + (size_t)(u.pm * BM + ai * HALF + wr * 64 + m * 16 + fr) * DFF + ch) = w; }
                    asm volatile("" ::: "memory");
                }
            }
        }
    }
};
struct EpiResidualNorm {
    static constexpr bool PERM = false, AFTER_DRAIN = false;
    const float* base; float* out; bf16_t* XG; const float* g; float* rss; bf16_t* AH;
    __device__ __forceinline__ void operator()(const f32x4 (&acc)[2][2][4][2], const Unit& u, int wr, int wc, int fr, int fq) const {
        const int col0 = u.pn * BM + wc * 32 + 4 * fq;
        f32x4 gv[2][2];
#pragma unroll
        for (int bj = 0; bj < 2; ++bj)
#pragma unroll
            for (int n = 0; n < 2; ++n) gv[bj][n] = g ? *(const f32x4*)(g + col0 + bj * HALF + n * 16) : (f32x4){0.f, 0.f, 0.f, 0.f};
#pragma unroll
        for (int ai = 0; ai < 2; ++ai)
#pragma unroll
            for (int m = 0; m < 4; ++m) { const int r = u.pm * BM + ai * HALF + wr * 64 + m * 16 + fr; const size_t off = (size_t)r * DM + col0;
                bf16_t* hrow = nullptr; if (AH && (r & 255) >= 254 && (r >> 8) < 63) hrow = AH + (size_t)(2 * ((r >> 8) + 1) + (r & 255) - 254) * DM + col0;
                float ss = 0.f;
#pragma unroll
                for (int bj = 0; bj < 2; ++bj)
#pragma unroll
                    for (int n = 0; n < 2; ++n) { const f32x4 bs = *(const f32x4*)(base + off + bj * HALF + n * 16); const f32x4 xn = bs + acc[ai][bj][m][n];
                        *(f32x4*)(out + off + bj * HALF + n * 16) = xn;
                        ss += (xn[0] * xn[0] + xn[1] * xn[1]) + (xn[2] * xn[2] + xn[3] * xn[3]);
                        if (XG) { const f32x4 y = xn * gv[bj][n]; u32x2 w; w.x = cvt_pk_bf16(y[0], y[1]); w.y = cvt_pk_bf16(y[2], y[3]);
                            *(u32x2*)(XG + off + bj * HALF + n * 16) = w; if (hrow) *(u32x2*)(hrow + bj * HALF + n * 16) = w; } }
                ss += __shfl_xor(ss, 16); ss += __shfl_xor(ss, 32);
                if (fq == 0) atomicAdd(rss + r, ss);
            }
    }
};
}
#define XB_TMO      128
#define XB_XCNT(j)  (256  + 64 * (j))
#define XB_XSUB(j)  (1280 + 64 * (j))
#define XB_XGEN(j)  (2304 + 64 * (j))
#define XB_TOP      3328
#define XB_TOPGEN   3392
#define XCD_BAR_WORDS 3456
#define XB_SPIN_CAP (1u << 18)

__device__ __forceinline__ unsigned xb_ld(unsigned* p)              { return __hip_atomic_load(p, __ATOMIC_RELAXED, __HIP_MEMORY_SCOPE_AGENT); }
__device__ __forceinline__ unsigned xb_add(unsigned* p, unsigned v) { return __hip_atomic_fetch_add(p, v, __ATOMIC_RELAXED, __HIP_MEMORY_SCOPE_AGENT); }
__device__ __forceinline__ unsigned xb_xcc_id() { return (unsigned)__builtin_amdgcn_s_getreg((3 << 11) | 20) & 0xFu; }
#define XB_SPIN(cond, bar) do { unsigned _sp = 0; while (cond) { __builtin_amdgcn_s_sleep(1); \
    if ((++_sp & 255u) == 0u) { if (xb_ld(&(bar)[XB_TMO])) break; if (_sp > XB_SPIN_CAP) { atomicAdd(&(bar)[XB_TMO], 1u); break; } } } } while (0)

struct XcdBarrier {
    unsigned* bar; unsigned x;
    volatile LAS unsigned* st;
};

__device__ __forceinline__ XcdBarrier xcd_barrier_post(unsigned* bar, volatile LAS unsigned* st) {
    XcdBarrier b; b.bar = bar; b.x = xb_xcc_id(); b.st = st;
    if (threadIdx.x == 0) (void)xb_add(&bar[XB_XCNT(b.x)], 1u);
    return b;
}
__device__ __forceinline__ void xcd_barrier_complete(unsigned* bar, unsigned x, unsigned& nloc, unsigned& nx) {
    const unsigned G = gridDim.x * gridDim.y * gridDim.z;
    unsigned sum, cnt, mine, sp = 0u;
    for (;;) {
        sum = 0u; cnt = 0u; mine = 0u;
#pragma unroll
        for (unsigned j = 0; j < 16; ++j) { const unsigned c = xb_ld(&bar[XB_XCNT(j)]); sum += c; cnt += (c > 0u) ? 1u : 0u; mine = (j == x) ? c : mine; }
        if (sum == G) break;
        __builtin_amdgcn_s_sleep(1);
        if ((++sp & 255u) == 0u) { if (xb_ld(&bar[XB_TMO])) break; if (sp > XB_SPIN_CAP) { atomicAdd(&bar[XB_TMO], 1u); break; } }
    }
    nloc = mine > 0u ? mine : 1u; nx = cnt > 0u ? cnt : 1u;
}

__device__ __forceinline__ void xcd_barrier(const XcdBarrier& b) {
    asm volatile("s_waitcnt vmcnt(0)" ::: "memory");
    __syncthreads();
    if (threadIdx.x == 0) {
        unsigned* bar = b.bar;
        __builtin_amdgcn_s_waitcnt(0);
        unsigned nloc = b.st[0], nx = b.st[1];
        if (nloc == 0u) { xcd_barrier_complete(bar, b.x, nloc, nx); b.st[0] = nloc; b.st[1] = nx; }
        const unsigned old = xb_add(&bar[XB_XSUB(b.x)], 1u);
        const unsigned gen = old / nloc;
        if (old + 1u == (gen + 1u) * nloc) {
            __builtin_amdgcn_fence(__ATOMIC_RELEASE, "agent");
            asm volatile("s_waitcnt vmcnt(0)" ::: "memory");
            const unsigned og = xb_add(&bar[XB_TOP], 1u);
            const unsigned tg = og / nx;
            if (og + 1u == (tg + 1u) * nx) xb_add(&bar[XB_TOPGEN], 1u);
            else XB_SPIN(xb_ld(&bar[XB_TOPGEN]) == tg, bar);
            __builtin_amdgcn_fence(__ATOMIC_ACQUIRE, "agent");
            xb_add(&bar[XB_XGEN(b.x)], 1u);
            asm volatile("s_waitcnt vmcnt(0)" ::: "memory");
        } else {
            XB_SPIN(xb_ld(&bar[XB_XGEN(b.x)]) == gen, bar);
            __builtin_amdgcn_fence(__ATOMIC_ACQUIRE, "agent");
            asm volatile("s_waitcnt vmcnt(0)" ::: "memory");
        }
    }
    __syncthreads();
}
#include <hip/hip_bf16.h>
#include <cmath>
namespace attn_body {
using bf16=__hip_bfloat16;
using bf16x8=__attribute__((ext_vector_type(8)))short;
using s16x4=__attribute__((ext_vector_type(4)))short;
using f32x16=__attribute__((ext_vector_type(16)))float;
using u32x4=__attribute__((ext_vector_type(4)))unsigned;
constexpr int BATCH=8,NHEAD=8,SEQ=2048,D=64,QPT=1536,KPT=1152,VPT=512;
constexpr int NW=8,QBLK=32,QB=QBLK*NW,KVBLK=64,NQB=SEQ/QB;
constexpr int ATTN_UNIT_ROWS=QB;
__device__ __forceinline__ int crow(int r,int hi){return (r&3)+8*(r>>2)+4*hi;}
#define SBAR() __builtin_amdgcn_sched_barrier(0)
__device__ __forceinline__ void cmask(f32x16&p0,f32x16&p1,int jb,int qrel,int hi){
  const float NEG=-INFINITY; int kb=64*jb+4*hi;
  #pragma unroll
  for(int r=0;r<16;++r){int kv=kb+(r&3)+8*(r>>2); if(kv>qrel)p0[r]=NEG; if(kv+32>qrel)p1[r]=NEG;}
}

constexpr int NSLOT=3, SLOTB=8192;
constexpr int LDS_K=0, LDS_V=NSLOT*SLOTB, LDS_WS=2*NSLOT*SLOTB, LDS_OST=LDS_WS+NW*64*4, LDS_BYTES=LDS_OST+NW*4096;
constexpr float C2=0.125f*1.4426950408889634f;
__device__ __forceinline__ void glds16(const void*gsrc,unsigned lds_dst){unsigned keep;
  asm volatile("s_mov_b32 %0, m0\n\ts_mov_b32 m0, %2\n\ts_nop 0\n\tglobal_load_lds_dwordx4 %1, off\n\ts_mov_b32 m0, %0":"=&s"(keep):"v"(gsrc),"s"(lds_dst):"memory");}
__device__ __forceinline__ float max3f(float a,float b,float c){float r;asm("v_max3_f32 %0, %1, %2, %3":"=v"(r):"v"(a),"v"(b),"v"(c));return r;}
__device__ __forceinline__ float max2f(float a,float b){float r;asm("v_max_f32_e32 %0, %1, %2":"=v"(r):"v"(a),"v"(b));return r;}
__device__ __forceinline__ float fadd_s(float a,float b){float r;asm("v_add_f32_e32 %0, %1, %2":"=v"(r):"v"(a),"v"(b));return r;}
__device__ __forceinline__ float fsub_s(float a,float b){float r;asm("v_sub_f32_e32 %0, %1, %2":"=v"(r):"v"(a),"v"(b));return r;}
typedef float f32x2_t __attribute__((ext_vector_type(2))); typedef __bf16 bf16x2_t __attribute__((ext_vector_type(2)));
__device__ __forceinline__ unsigned cvtpk_s(float lo,float hi){f32x2_t v={lo,hi};bf16x2_t b=__builtin_convertvector(v,bf16x2_t);return __builtin_bit_cast(unsigned,b);}
#define WAIT_BAR(N) asm volatile("s_waitcnt vmcnt(" #N ") lgkmcnt(0)\n\ts_barrier":::"memory")

__device__ __forceinline__ void qkt(f32x16&p0,f32x16&p1,const char*Kslot,const bf16x8*qr,const f32x16&negm,int r32,int hi){
  const char*kb=Kslot+hi*1024+r32*16;
  #pragma unroll
  for(int d0=0;d0<4;++d0){
    const bf16x8 b0=*reinterpret_cast<const bf16x8*>(kb+d0*2048);
    const bf16x8 b1=*reinterpret_cast<const bf16x8*>(kb+d0*2048+512);
    if(d0==0){p0=__builtin_amdgcn_mfma_f32_32x32x16_bf16(b0,qr[0],negm,0,0,0);p1=__builtin_amdgcn_mfma_f32_32x32x16_bf16(b1,qr[0],negm,0,0,0);}
    else{p0=__builtin_amdgcn_mfma_f32_32x32x16_bf16(b0,qr[d0],p0,0,0,0);p1=__builtin_amdgcn_mfma_f32_32x32x16_bf16(b1,qr[d0],p1,0,0,0);}}
}
typedef __attribute__((address_space(3))) const char* lds_cptr;
typedef short v4i16_t __attribute__((ext_vector_type(4)));
__device__ __forceinline__ void kload8(bf16x8*kf,lds_cptr kp){
  kf[0]=*(const __attribute__((address_space(3))) bf16x8*)(kp);      kf[1]=*(const __attribute__((address_space(3))) bf16x8*)(kp+512);
  kf[2]=*(const __attribute__((address_space(3))) bf16x8*)(kp+2048); kf[3]=*(const __attribute__((address_space(3))) bf16x8*)(kp+2560);
  kf[4]=*(const __attribute__((address_space(3))) bf16x8*)(kp+4096); kf[5]=*(const __attribute__((address_space(3))) bf16x8*)(kp+4608);
  kf[6]=*(const __attribute__((address_space(3))) bf16x8*)(kp+6144); kf[7]=*(const __attribute__((address_space(3))) bf16x8*)(kp+6656);
}
__device__ __forceinline__ void kload2(bf16x8*kf,lds_cptr kp,int j){ kf[2*j]=*(const __attribute__((address_space(3))) bf16x8*)(kp+j*2048); kf[2*j+1]=*(const __attribute__((address_space(3))) bf16x8*)(kp+j*2048+512); }
__device__ __forceinline__ s16x4 vtr(lds_cptr p){ return __builtin_bit_cast(s16x4,__builtin_amdgcn_ds_read_tr16_b64_v4i16((__attribute__((address_space(3))) v4i16_t*)p)); }
__device__ __forceinline__ float rowmax(const f32x16&p0,const f32x16&p1){
  float a=max3f(p0[0],p0[1],p1[0]),b=max3f(p0[2],p0[3],p1[1]);a=max3f(a,p1[2],p1[3]);
  #pragma unroll
  for(int r=4;r<16;r+=4){a=max3f(a,p0[r],p0[r+1]);b=max3f(b,p0[r+2],p0[r+3]);a=max3f(a,p1[r],p1[r+1]);b=max3f(b,p1[r+2],p1[r+3]);}
  const float m=max2f(a,b);
  auto rr=__builtin_amdgcn_permlane32_swap(__float_as_uint(m),__float_as_uint(m),false,false);
  return max2f(__uint_as_float(rr[0]),__uint_as_float(rr[1]));
}
__device__ __forceinline__ void pv(f32x16*o,int vb,bf16x8 pa0,bf16x8 pa1,bf16x8 pa2,bf16x8 pa3){
  #pragma unroll
  for(int d0=0;d0<2;++d0){s16x4 lo[4],hi[4];
    #pragma unroll
    for(int ks=0;ks<4;++ks){
      asm volatile("ds_read_b64_tr_b16 %0,%1 offset:%c2":"=&v"(lo[ks]):"v"(vb),"i"(d0*4096+ks*1024):"memory");
      asm volatile("ds_read_b64_tr_b16 %0,%1 offset:%c2":"=&v"(hi[ks]):"v"(vb),"i"(d0*4096+ks*1024+512):"memory");}
    asm volatile("s_waitcnt lgkmcnt(0)":::"memory");SBAR();
    #define PK(k) (bf16x8){lo[k][0],lo[k][1],lo[k][2],lo[k][3],hi[k][0],hi[k][1],hi[k][2],hi[k][3]}
    o[d0]=__builtin_amdgcn_mfma_f32_32x32x16_bf16(pa0,PK(0),o[d0],0,0,0);
    o[d0]=__builtin_amdgcn_mfma_f32_32x32x16_bf16(pa1,PK(1),o[d0],0,0,0);
    o[d0]=__builtin_amdgcn_mfma_f32_32x32x16_bf16(pa2,PK(2),o[d0],0,0,0);
    o[d0]=__builtin_amdgcn_mfma_f32_32x32x16_bf16(pa3,PK(3),o[d0],0,0,0);
    #undef PK
  }
}

#ifndef ATTN_STORE16
#define ATTN_STORE16(p,v) (*(u32x4*)(p)=(v))
#endif
template<int THRL> __device__ __forceinline__ void attn_unit(int b,int h,int qb,const bf16*Q,const bf16*__restrict__ K,const bf16*__restrict__ V,bf16*O,char*shm,const float*KP){
  int tid_=threadIdx.x; asm volatile("":"+v"(tid_));
  const int tid=tid_,lane=tid&63,r32=lane&31,hi=lane>>5; const int wid=__builtin_amdgcn_readfirstlane(tid>>6);
  const long rowbase=(long)b*SEQ; const int q0=qb*QB;
  const bf16*Qw=Q+(rowbase+q0+wid*QBLK)*QPT+h*D;
  const bf16*Kh=K+rowbase*KPT+h*D,*Vh=V+rowbase*VPT+h*D;
  const unsigned lds0=(unsigned)(uintptr_t)shm;
  float*wsf=(float*)(shm+LDS_WS)+wid*64;
  const bf16*ksrc=Kh+(long)lane*KPT+wid*8;
  const bf16*vsrc=Vh+(long)(16*(wid&3)+(lane>>2))*VPT+(wid>>2)*32+(lane&3)*8;
  const unsigned kdst=lds0+LDS_K+wid*1024, vdst=lds0+LDS_V+wid*1024;
  #define DMA_K(t,slot) glds16(ksrc+(long)(t)*KVBLK*KPT,(unsigned)__builtin_amdgcn_readfirstlane(kdst+(slot)))
  #define DMA_V(t,slot) glds16(vsrc+(long)(t)*KVBLK*VPT,(unsigned)__builtin_amdgcn_readfirstlane(vdst+(slot)))
  const int vb0=(int)(lds0+LDS_V)+((lane>>4)&1)*32+(lane&3)*8+(4*hi+((lane&15)>>2))*64;
  const char*Kbase=shm+LDS_K; bf16x8 kf[8];
  const lds_cptr shm3=(lds_cptr)shm; const lds_cptr kp0=shm3+LDS_K+hi*1024+r32*16; const lds_cptr vp0=shm3+LDS_V+((lane>>4)&1)*32+(lane&3)*8+(4*hi+((lane&15)>>2))*64;
  const int NT=(q0+QB)/KVBLK;
  unsigned sel=0u; const bool domask=(qb>3);
  if(domask){
    float*km=(float*)(shm+86016);
    { const int n=tid>>6,d=tid&63; float v=0.f; if(n<qb){ const float*p=KP+(size_t)((b*8+n)*2)*512+h*64+d; v=p[0]+p[512]; } km[n*64+d]=v; }
    __syncthreads();
    float g4[4]={0.f,0.f,0.f,0.f};
    #pragma unroll
    for(int k=0;k<8;++k){ const bf16x8 qv=*reinterpret_cast<const bf16x8*>(&Qw[(long)r32*QPT+8*k]);
      #pragma unroll
      for(int e=0;e<8;++e){ const float qe=__uint_as_float(((unsigned)(unsigned short)qv[e])<<16);
        #pragma unroll
        for(int n4=0;n4<4;++n4) g4[n4]+=qe*km[(hi*4+n4)*64+8*k+e]; } }
    float g[8];
    #pragma unroll
    for(int n4=0;n4<4;++n4){ const float go=__shfl(g4[n4],lane^32); g[n4]=hi?go:g4[n4]; g[4+n4]=hi?g4[n4]:go; }
    #pragma unroll
    for(int n=0;n<8;++n){ int cnt=0;
      #pragma unroll
      for(int n2=0;n2<8;++n2) if(n2!=n) cnt+=(n2<qb&&((g[n2]>g[n])||(g[n2]==g[n]&&n2<n)))?1:0;
      if(n<qb&&cnt<3) sel|=(1u<<n); }
    __syncthreads();
  }
  DMA_K(0,0);DMA_V(0,0);DMA_K(1,SLOTB);
  bf16x8 qr[4];
  #pragma unroll
  for(int d0=0;d0<4;++d0)qr[d0]=*reinterpret_cast<const bf16x8*>(&Qw[(long)r32*QPT+d0*16+hi*8]);
  float mhat=0.f,l_reg=0.f;f32x16 o[2];o[0]=f32x16{};o[1]=f32x16{};f32x16 negm=f32x16{};asm volatile("":"+v"(negm));
  const int qrel=wid*QBLK+r32;
  #define CMASK(P0,P1,t) do{int jb_=(t)-(NT-4); if(jb_>=0)cmask(P0,P1,jb_,qrel,hi); else if(domask){ if(!((sel>>((t)>>2))&1u)){ _Pragma("unroll") for(int r_=0;r_<16;++r_){P0[r_]=-1e30f;P1[r_]=-1e30f;} } } }while(0)
  bool resc=false;
  #define START(P0,P1) do{ const float rm=rowmax(P0,P1); resc=false; \
    { const float dl=__builtin_fmaxf(rm,-30000.f); mhat=fadd_s(mhat,dl); \
      _Pragma("unroll") for(int r=0;r<16;++r){P0[r]=fsub_s(P0[r],dl);P1[r]=fsub_s(P1[r],dl);} \
      _Pragma("unroll") for(int r=0;r<16;++r)negm[r]=-mhat; asm volatile("":"+v"(negm)); } \
    _Pragma("unroll") for(int r=0;r<16;++r)P0[r]=__builtin_amdgcn_exp2f(P0[r]); }while(0)
  #define RESC() do{ if(resc){ asm volatile("s_waitcnt lgkmcnt(0)":::"memory"); \
      _Pragma("unroll") for(int d_=0;d_<2;++d_) _Pragma("unroll") for(int r=0;r<16;++r)o[d_][r]*=wsf[crow(r,hi)]; } }while(0)
  f32x16 pA0,pA1,pB0,pB1;
  int sl_prev=0,sl_cur=0,sl_next=SLOTB;
  #define ROT() do{sl_prev=sl_cur;sl_cur=sl_next;sl_next=(sl_next==(NSLOT-1)*SLOTB)?0:sl_next+SLOTB;}while(0)
  DMA_K(2,2*SLOTB);
  WAIT_BAR(3);
  qkt(pA0,pA1,Kbase,qr,negm,r32,hi);asm volatile("s_nop 15\n\ts_nop 7":"+v"(pA0),"+v"(pA1));CMASK(pA0,pA1,0);
  START(pA0,pA1);
  _Pragma("unroll") for(int r=0;r<16;++r)pA1[r]=__builtin_amdgcn_exp2f(pA1[r]);
  WAIT_BAR(0);
  DMA_K(3,0);DMA_V(1,SLOTB);
  ROT();
  kload8(kf,kp0+sl_cur);
  WAIT_BAR(2);
  s16x4 vlo[8],vhi[8]; u32x4 pw0,pw1,pw2,pw3;
  #define PKW(P,B) cvtpk_s(P[B],P[B+1])
  #define PAF(k) __builtin_bit_cast(bf16x8,pw##k)
  #define VFR(i) (bf16x8){vlo[i][0],vlo[i][1],vlo[i][2],vlo[i][3],vhi[i][0],vhi[i][1],vhi[i][2],vhi[i][3]}
  #define PIN(x) asm volatile("":"+v"(x))
  #define MX3(a,b,c) __builtin_fmaxf(__builtin_fmaxf((a),(b)),(c))
  #define GAPA(MF,A0,A1,A2,A3,W0,W1,PW) do{ MF; sacc+=A0; sacc+=A1; sacc+=A2; sacc+=A3; PIN(sacc); W0; W1; PIN(PW); SBAR(); }while(0)
  #define EX(v) __builtin_amdgcn_exp2f(v)
  #define GAPB(MF,X,B) do{ MF; X[B]=EX(X[B]); X[B+1]=EX(X[B+1]); X[B+2]=EX(X[B+2]); X[B+3]=EX(X[B+3]); PIN(X); SBAR(); }while(0)
  #define VRD(i) do{ vlo[i]=vtr(vp_+(((i)>>2)*4096+((i)&3)*1024)); vhi[i]=vtr(vp_+(((i)>>2)*4096+((i)&3)*1024+512)); }while(0)
  #define KRD(G,j) do{ if(G){ kload2(kf,kp0+sl_next,j); SBAR(); } }while(0)
  #define STEP(C0,C1,P0,P1,t,GK,GV,GL) do{ SBAR(); \
    const lds_cptr vp_=vp0+sl_prev; \
    VRD(0); SBAR(); float sacc=(P0[0]+P0[1]); \
    GAPA(C0=__builtin_amdgcn_mfma_f32_32x32x16_bf16(kf[0],qr[0],negm,0,0,0), P0[2],P0[3],P0[4],P0[5],     pw0[0]=PKW(P0,0), pw0[1]=PKW(P0,2), pw0); \
    VRD(4); SBAR(); GAPA(C1=__builtin_amdgcn_mfma_f32_32x32x16_bf16(kf[1],qr[0],negm,0,0,0), P0[6],P0[7],P0[8],P0[9],     pw0[2]=PKW(P0,4), pw0[3]=PKW(P0,6), pw0); \
    VRD(1); SBAR(); GAPA(C0=__builtin_amdgcn_mfma_f32_32x32x16_bf16(kf[2],qr[1],C0,0,0,0),   P0[10],P0[11],P0[12],P0[13], pw1[0]=PKW(P0,8), pw1[1]=PKW(P0,10), pw1); \
    VRD(5); SBAR(); GAPA(C1=__builtin_amdgcn_mfma_f32_32x32x16_bf16(kf[3],qr[1],C1,0,0,0),   P0[14],P0[15],P1[0],P1[1],   pw1[2]=PKW(P0,12),pw1[3]=PKW(P0,14), pw1); \
    VRD(2); SBAR(); GAPA(C0=__builtin_amdgcn_mfma_f32_32x32x16_bf16(kf[4],qr[2],C0,0,0,0),   P1[2],P1[3],P1[4],P1[5],     pw2[0]=PKW(P1,0), pw2[1]=PKW(P1,2), pw2); \
    VRD(6); SBAR(); GAPA(C1=__builtin_amdgcn_mfma_f32_32x32x16_bf16(kf[5],qr[2],C1,0,0,0),   P1[6],P1[7],P1[8],P1[9],     pw2[2]=PKW(P1,4), pw2[3]=PKW(P1,6), pw2); \
    VRD(3); SBAR(); GAPA(C0=__builtin_amdgcn_mfma_f32_32x32x16_bf16(kf[6],qr[3],C0,0,0,0),   P1[10],P1[11],P1[12],P1[13], pw3[0]=PKW(P1,8), pw3[1]=PKW(P1,10), pw3); \
    VRD(7); SBAR(); GAPA(C1=__builtin_amdgcn_mfma_f32_32x32x16_bf16(kf[7],qr[3],C1,0,0,0),   P1[14],P1[15],0.f,0.f,       pw3[2]=PKW(P1,12),pw3[3]=PKW(P1,14), pw3); \
    l_reg+=sacc; \
    if(GK){DMA_K((t)+3,sl_cur);} if(GV){DMA_V((t)+1,sl_next);} \
    CMASK(C0,C1,t); \
    { float a=MX3(C0[0],C0[1],C1[0]),b=MX3(C0[2],C0[3],C1[1]); a=MX3(a,C1[2],C1[3]); \
      _Pragma("unroll") for(int r=4;r<16;r+=4){a=MX3(a,C0[r],C0[r+1]);b=MX3(b,C0[r+2],C0[r+3]);a=MX3(a,C1[r],C1[r+1]);b=MX3(b,C1[r+2],C1[r+3]);} \
      float rm=__builtin_fmaxf(a,b); { auto rr=__builtin_amdgcn_permlane32_swap(__float_as_uint(rm),__float_as_uint(rm),false,false); rm=__builtin_fmaxf(__uint_as_float(rr[0]),__uint_as_float(rr[1])); } \
      resc=false; \
      if(__builtin_expect(__any(rm>(float)THRL),0)){ const float dl=__builtin_fmaxf(rm,0.f); mhat+=dl; \
        _Pragma("unroll") for(int r=0;r<16;++r){C0[r]-=dl;C1[r]-=dl;} \
        _Pragma("unroll") for(int r=0;r<16;++r)negm[r]=-mhat; asm volatile("":"+v"(negm)); \
        const float f=__builtin_amdgcn_exp2f(-dl); l_reg*=f; if(hi==0)wsf[r32]=f; resc=true; } } \
    SBAR(); \
    GAPB(o[0]=__builtin_amdgcn_mfma_f32_32x32x16_bf16(PAF(0),VFR(0),o[0],0,0,0), C0,0); \
    GAPB(o[1]=__builtin_amdgcn_mfma_f32_32x32x16_bf16(PAF(0),VFR(4),o[1],0,0,0), C0,4); \
    KRD(GL,0); GAPB(o[0]=__builtin_amdgcn_mfma_f32_32x32x16_bf16(PAF(1),VFR(1),o[0],0,0,0), C0,8); \
    KRD(GL,1); GAPB(o[1]=__builtin_amdgcn_mfma_f32_32x32x16_bf16(PAF(1),VFR(5),o[1],0,0,0), C0,12); \
    KRD(GL,2); GAPB(o[0]=__builtin_amdgcn_mfma_f32_32x32x16_bf16(PAF(2),VFR(2),o[0],0,0,0), C1,0); \
    KRD(GL,3); GAPB(o[1]=__builtin_amdgcn_mfma_f32_32x32x16_bf16(PAF(2),VFR(6),o[1],0,0,0), C1,4); \
    GAPB(o[0]=__builtin_amdgcn_mfma_f32_32x32x16_bf16(PAF(3),VFR(3),o[0],0,0,0), C1,8); \
    GAPB(o[1]=__builtin_amdgcn_mfma_f32_32x32x16_bf16(PAF(3),VFR(7),o[1],0,0,0), C1,12); \
    }while(0)
  int t=1;
  #undef CMASK
  #define CMASK(P0,P1,t) do{int jb_=(t)-(NT-4); if(jb_>=0)cmask(P0,P1,jb_,qrel,hi); else if(domask){ if(!((sel>>((t)>>2))&1u)){ _Pragma("unroll") for(int r_=0;r_<16;++r_){P0[r_]=-1e30f;P1[r_]=-1e30f;} } } }while(0)
  for(;t+5<NT;t+=2){
    STEP(pB0,pB1,pA0,pA1,t,true,true,true);     WAIT_BAR(2); RESC(); ROT();
    STEP(pA0,pA1,pB0,pB1,t+1,true,true,true);   WAIT_BAR(2); RESC(); ROT();
  }
  #undef CMASK
  #define CMASK(P0,P1,t) do{int jb_=(t)-(NT-4); if(jb_>=0)cmask(P0,P1,jb_,qrel,hi); else if(domask){ if(!((sel>>((t)>>2))&1u)){ _Pragma("unroll") for(int r_=0;r_<16;++r_){P0[r_]=-1e30f;P1[r_]=-1e30f;} } } }while(0)
  #define ENDW(tt) do{ if((tt)+3<NT){WAIT_BAR(2);} else if((tt)+2<NT){WAIT_BAR(1);} else {WAIT_BAR(0);} }while(0)
  for(;t+1<NT;t+=2){
    STEP(pB0,pB1,pA0,pA1,t,(t+3<NT),(t+1<NT),(t+1<NT));       ENDW(t);   RESC(); ROT();
    STEP(pA0,pA1,pB0,pB1,t+1,(t+4<NT),(t+2<NT),(t+2<NT));     ENDW(t+1); RESC(); ROT();
  }
  STEP(pB0,pB1,pA0,pA1,NT-1,false,false,false); RESC();
  { float sacc=pB0[0]+pB0[1]; _Pragma("unroll") for(int r=2;r<16;++r)sacc+=pB0[r]; _Pragma("unroll") for(int r=0;r<16;++r)sacc+=pB1[r]; l_reg+=sacc;
    pw0=(u32x4){PKW(pB0,0),PKW(pB0,2),PKW(pB0,4),PKW(pB0,6)};pw1=(u32x4){PKW(pB0,8),PKW(pB0,10),PKW(pB0,12),PKW(pB0,14)};pw2=(u32x4){PKW(pB1,0),PKW(pB1,2),PKW(pB1,4),PKW(pB1,6)};pw3=(u32x4){PKW(pB1,8),PKW(pB1,10),PKW(pB1,12),PKW(pB1,14)};
    SBAR(); pv(o,vb0+sl_cur,PAF(0),PAF(1),PAF(2),PAF(3)); }
  #undef PKW
  #undef PAF
  #undef VFR
  #undef PIN
  #undef MX3
  #undef GAPA
  #undef GAPB
  #undef EX
  #undef VRD
  #undef KRD
  #undef STEP
  #undef ENDW
  {auto rr=__builtin_amdgcn_permlane32_swap(__float_as_uint(l_reg),__float_as_uint(l_reg),false,false);l_reg=__uint_as_float(rr[0])+__uint_as_float(rr[1]);}
  if(hi==0)wsf[32+r32]=l_reg;asm volatile("s_waitcnt lgkmcnt(0)":::"memory");
  float rli[16];
  #pragma unroll
  for(int r=0;r<16;++r)rli[r]=__builtin_amdgcn_rcpf(wsf[32+crow(r,hi)]);
  bf16*Ow=O+(rowbase+q0+wid*QBLK)*QPT+h*D;
  { bf16*stg=(bf16*)(shm+LDS_OST)+wid*2048;
    #pragma unroll
    for(int r=0;r<16;++r){const int orow=crow(r,hi);
      #pragma unroll
      for(int d0=0;d0<2;++d0)stg[orow*64+d0*32+r32]=__float2bfloat16(o[d0][r]*rli[r]);}
    asm volatile("s_waitcnt lgkmcnt(0)":::"memory");
    #pragma unroll
    for(int i=0;i<4;++i){const int row=i*8+(lane>>3),ch=lane&7; const u32x4 v=*(const u32x4*)(stg+row*64+ch*8); ATTN_STORE16(Ow+(long)row*QPT+ch*8,v);} }
  asm volatile("s_waitcnt lgkmcnt(0)\n\ts_barrier":::"memory");
  #undef DMA_K
  #undef DMA_V
  #undef CMASK
  #undef START
  #undef RESC
  #undef ROT
}
constexpr int ATTN_LDS_BYTES=LDS_BYTES;

#undef SBAR
#undef WAIT_BAR
}
namespace att {
constexpr int LP = 72;
constexpr int VP = 136;
constexpr int KT_BYTES = 128 * LP * 2;
constexpr int VT_BYTES = 64 * VP * 2;
constexpr int BUF_BYTES = KT_BYTES + VT_BYTES;
constexpr int KM_OFF = 2 * BUF_BYTES;
constexpr int UNIT_OFF = 90112;
constexpr int DONE_OFF = UNIT_OFF + 64;
constexpr int NUNITS = 3 * 1024;
__device__ __forceinline__ f32x4 mfma16(bf16x8 a, bf16x8 b, f32x4 c) { return __builtin_amdgcn_mfma_f32_16x16x32_bf16(a, b, c, 0, 0, 0); }

template <int MODE>
__device__ __forceinline__ void attn_unit(LAS unsigned char* lds, bf16_t* Qb, const bf16_t* Kb, const bf16_t* VT, const float* KP, const float* sinks, int b, int h, int qt, bool dry = false) {
    int tid_ = threadIdx.x; asm volatile("" : "+v"(tid_));
    const int tid = tid_, lane = tid & 63, wid = __builtin_amdgcn_readfirstlane(tid >> 6), l15 = lane & 15, q4 = lane >> 4;
    const int t0 = qt * 128, tw = t0 + 16 * wid, tq = tw + l15;
    const size_t rowq = (size_t)b * SEQ + tq;
    int qcol, kcol, vh;
    if (MODE == 0) { qcol = h * 64; kcol = (h >> 2) * 64; vh = h >> 2; }
    else if (MODE == 1) { qcol = 512 + h * 64; kcol = 128 + h * 64; vh = 2 + h; }
    else { qcol = 1024 + h * 64; kcol = 640 + h * 64; vh = 10 + h; }
    bf16_t* Qrow = Qb + rowq * QPITCH + qcol;
    bf16x8 qf[2];
    qf[0] = *(const bf16x8*)(Qrow + 8 * q4); qf[1] = *(const bf16x8*)(Qrow + 32 + 8 * q4);
    const bf16_t* Kg = Kb + (size_t)b * SEQ * KPITCH + kcol;
    const bf16_t* Vg = VT + (size_t)(b * NVH + vh) * 64 * SEQ;
    const int srow = tid >> 3, sch = tid & 7;
    const int Tlast = qt;
    int Tfirst = 0; if (MODE == 0) { Tfirst = qt - 1; if (Tfirst < 0) Tfirst = 0; }
    const int nT = Tlast - Tfirst + 1;
    const int srow2 = tid >> 4, sch2 = tid & 15;
    unsigned sel = 0u; const int jblk = t0 >> 8;
    if (MODE == 2) {
        LAS float* km = (LAS float*)(lds + KM_OFF);
        { const int n = tid >> 6, d = tid & 63; float v = 0.f;
          if (n < jblk) { const float* p = KP + (size_t)((b * 8 + n) * 2) * 512 + h * 64 + d; v = p[0] + p[512]; }
          km[n * 64 + d] = v; }
        __syncthreads();
        float g0 = 0.f, g1 = 0.f;
#pragma unroll
        for (int k = 0; k < 8; ++k) { const bf16x8 qv = *(const bf16x8*)(Qrow + 8 * k);
#pragma unroll
            for (int e = 0; e < 8; ++e) { const float qe = bf2f((unsigned short)qv[e]); g0 += qe * km[q4 * 64 + 8 * k + e]; g1 += qe * km[(q4 + 4) * 64 + 8 * k + e]; } }
        float g[8];
#pragma unroll
        for (int n = 0; n < 8; ++n) g[n] = __shfl((n < 4) ? g0 : g1, l15 + 16 * (n & 3));
#pragma unroll
        for (int n = 0; n < 8; ++n) { int cnt = 0;
#pragma unroll
            for (int n2 = 0; n2 < 8; ++n2) if (n2 != n) cnt += (n2 < jblk && ((g[n2] > g[n]) || (g[n2] == g[n] && n2 < n))) ? 1 : 0;
            if (n < jblk && cnt < 3) sel |= (1u << n); }
    }
    bf16x8 u00, u10, u21, u31, uall;
    if (MODE == 1) {
#pragma unroll
        for (int j = 0; j < 8; ++j) { const int kin = 16 * (j >> 2) + 4 * q4 + (j & 3);
            u00[j] = (kin >= l15) ? (short)0x3F80 : (short)0; u10[j] = (kin >= 16 + l15) ? (short)0x3F80 : (short)0;
            u21[j] = (kin >= l15) ? (short)0x3F80 : (short)0; u31[j] = (kin >= 16 + l15) ? (short)0x3F80 : (short)0; uall[j] = (short)0x3F80; }
    }
    float mrun = -1e30f, lsum = 0.f, carry = 0.f; bool sbdone = false;
    if (MODE == 0) { mrun = sinks[h] * LOG2E; lsum = (q4 == 0) ? 1.f : 0.f; }
    f32x4 o[4];
#pragma unroll
    for (int dd = 0; dd < 4; ++dd) o[dd] = (f32x4){0.f, 0.f, 0.f, 0.f};
    u32x4 kreg0, kreg1, vreg0, vreg1;
#define ATT_LOAD(ks_) do { kreg0 = *(const u32x4*)(Kg + (size_t)((ks_) + srow) * KPITCH + sch * 8); kreg1 = *(const u32x4*)(Kg + (size_t)((ks_) + 64 + srow) * KPITCH + sch * 8); \
        vreg0 = *(const u32x4*)(Vg + (size_t)srow2 * SEQ + (ks_) + sch2 * 8); vreg1 = *(const u32x4*)(Vg + (size_t)(32 + srow2) * SEQ + (ks_) + sch2 * 8); } while (0)
#define ATT_STORE(buf_) do { LAS unsigned char* b_ = lds + (buf_) * BUF_BYTES; *(LAS u32x4*)(b_ + (srow * LP + sch * 8) * 2) = kreg0; *(LAS u32x4*)(b_ + ((64 + srow) * LP + sch * 8) * 2) = kreg1; \
        *(LAS u32x4*)(b_ + KT_BYTES + (srow2 * VP + sch2 * 8) * 2) = vreg0; *(LAS u32x4*)(b_ + KT_BYTES + ((32 + srow2) * VP + sch2 * 8) * 2) = vreg1; } while (0)
    { const int T = (MODE == 1) ? Tlast : Tfirst; ATT_LOAD(128 * T); ATT_STORE(0); }
    __syncthreads();
    for (int i = 0; i < nT; ++i) {
        const int T = (MODE == 1) ? (Tlast - i) : (Tfirst + i);
        if (i + 1 < nT) { const int Tn = (MODE == 1) ? (T - 1) : (T + 1); ATT_LOAD(128 * Tn); }
#pragma unroll
        for (int hh = 0; hh < 2; ++hh) {
        const int h2 = (MODE == 1) ? (1 - hh) : hh, ks = 128 * T + 64 * h2;
        LAS unsigned char* Kl = lds + (i & 1) * BUF_BYTES + h2 * (64 * LP * 2); LAS unsigned char* Vl = lds + (i & 1) * BUF_BYTES + KT_BYTES + h2 * 128;
        bool need;
        if (MODE == 0) need = (ks <= tw + 15) && (ks + 63 > tw - 128);
        else if (MODE == 1) need = (ks < tw + 15) && !sbdone;
        else need = (ks <= tw + 15);
        if (need) {
            f32x4 st[4];
#pragma unroll
            for (int s = 0; s < 4; ++s) { st[s] = (f32x4){0.f, 0.f, 0.f, 0.f};
#pragma unroll
                for (int c = 0; c < 2; ++c) { const bf16x8 a = *(const LAS bf16x8*)(Kl + ((16 * s + l15) * LP + 32 * c + 8 * q4) * 2); st[s] = mfma16(a, qf[c], st[s]); } }
            bf16x8 pf[2];
            if (MODE != 1) {
                bool blkok = true; const bool pastblk = (MODE == 2) && ((ks >> 8) < jblk); if (MODE == 2) { const int n = ks >> 8; if (n < jblk) blkok = ((sel >> n) & 1u) != 0u; }
                float mx = -INFINITY;
#pragma unroll
                for (int s = 0; s < 4; ++s)
#pragma unroll
                    for (int r = 0; r < 4; ++r) { const int key = ks + 16 * s + 4 * q4 + r; bool ok;
                        if (MODE == 0) ok = (key <= tq) && (key > tq - 128); else ok = blkok && (pastblk || key <= tq);
                        const float v = ok ? st[s][r] : -INFINITY; st[s][r] = v; mx = fmaxf(mx, v); }
                mx = fmaxf(mx, __shfl_xor(mx, 16)); mx = fmaxf(mx, __shfl_xor(mx, 32));
                const float mnew = fmaxf(mrun, mx), alpha = fast_exp2(mrun - mnew); mrun = mnew;
                float ps = 0.f;
#pragma unroll
                for (int s = 0; s < 4; ++s)
#pragma unroll
                    for (int r = 0; r < 4; ++r) { const float p = fast_exp2(st[s][r] - mnew); st[s][r] = p; ps += p; }
                lsum = lsum * alpha + ps;
#pragma unroll
                for (int dd = 0; dd < 4; ++dd) o[dd] = o[dd] * alpha;
            } else {
                float sp[4][4]; bf16x8 bh[2], bl[2];
#pragma unroll
                for (int s = 0; s < 4; ++s)
#pragma unroll
                    for (int r = 0; r < 4; ++r) { const int key = ks + 16 * s + 4 * q4 + r; const float z = st[s][r];
                        float v = fmaxf(z, 0.f) + fast_log2(1.f + fast_exp2(-fabsf(z))); sp[s][r] = (key < tq) ? v : 0.f; }
#pragma unroll
                for (int c = 0; c < 2; ++c) { u32x4 wh, wl;
#pragma unroll
                    for (int k = 0; k < 4; ++k) { const int s = 2 * c + (k >> 1), r = 2 * (k & 1);
                        const unsigned hw = cvtpk(sp[s][r], sp[s][r + 1]);
                        const float l0 = sp[s][r] - __uint_as_float(hw << 16), l1 = sp[s][r + 1] - __uint_as_float(hw & 0xffff0000u);
                        wh[k] = hw; wl[k] = cvtpk(l0, l1); }
                    bh[c] = __builtin_bit_cast(bf16x8, wh); bl[c] = __builtin_bit_cast(bf16x8, wl); }
                f32x4 ct[4];
#pragma unroll
                for (int s = 0; s < 4; ++s) ct[s] = (f32x4){carry, carry, carry, carry};
                ct[0] = mfma16(u00, bh[0], ct[0]); ct[0] = mfma16(u00, bl[0], ct[0]); ct[0] = mfma16(uall, bh[1], ct[0]); ct[0] = mfma16(uall, bl[1], ct[0]);
                ct[1] = mfma16(u10, bh[0], ct[1]); ct[1] = mfma16(u10, bl[0], ct[1]); ct[1] = mfma16(uall, bh[1], ct[1]); ct[1] = mfma16(uall, bl[1], ct[1]);
                ct[2] = mfma16(u21, bh[1], ct[2]); ct[2] = mfma16(u21, bl[1], ct[2]);
                ct[3] = mfma16(u31, bh[1], ct[3]); ct[3] = mfma16(u31, bl[1], ct[3]);
#pragma unroll
                for (int s = 0; s < 4; ++s)
#pragma unroll
                    for (int r = 0; r < 4; ++r) { const int key = ks + 16 * s + 4 * q4 + r; const float w = fast_exp2(st[s][r] - ct[s][r]); st[s][r] = (key < tq) ? w : 0.f; }
                carry = __shfl(ct[0][0], l15);
                { float cm = carry; cm = fminf(cm, __shfl_xor(cm, 1)); cm = fminf(cm, __shfl_xor(cm, 2)); cm = fminf(cm, __shfl_xor(cm, 4)); cm = fminf(cm, __shfl_xor(cm, 8)); sbdone = cm > 48.f; }
            }
#pragma unroll
            for (int c = 0; c < 2; ++c) { u32x4 w; w.x = cvtpk(st[2 * c][0], st[2 * c][1]); w.y = cvtpk(st[2 * c][2], st[2 * c][3]); w.z = cvtpk(st[2 * c + 1][0], st[2 * c + 1][1]); w.w = cvtpk(st[2 * c + 1][2], st[2 * c + 1][3]);
                pf[c] = __builtin_bit_cast(bf16x8, w); }
#pragma unroll
            for (int dd = 0; dd < 4; ++dd)
#pragma unroll
                for (int c = 0; c < 2; ++c) {
                    const s16x4 v0 = *(const LAS s16x4*)(Vl + ((16 * dd + l15) * VP + 32 * c + 4 * q4) * 2), v1 = *(const LAS s16x4*)(Vl + ((16 * dd + l15) * VP + 32 * c + 16 + 4 * q4) * 2);
                    const bf16x8 a = {v0[0], v0[1], v0[2], v0[3], v1[0], v1[1], v1[2], v1[3]};
                    o[dd] = mfma16(a, pf[c], o[dd]); }
        }
        }
        if (i + 1 < nT) ATT_STORE((i + 1) & 1);
        if (MODE == 1) { if (lane == 0) ((LAS int*)(lds + DONE_OFF))[wid * 2 + (i & 1)] = sbdone ? 1 : 0; }
        __syncthreads();
        if (MODE == 1) { const LAS int* df = (const LAS int*)(lds + DONE_OFF) + (i & 1); int all = 1;
#pragma unroll
            for (int w = 0; w < 8; ++w) all &= df[2 * w];
            if (all) break; }
    }
    if (MODE == 1) __syncthreads();
#undef ATT_LOAD
#undef ATT_STORE
    float inv = 1.f;
    if (MODE != 1) { lsum += __shfl_xor(lsum, 16); lsum += __shfl_xor(lsum, 32); inv = 1.f / lsum; }
    if (!dry || lsum == 12345.678f)
#pragma unroll
    for (int dd = 0; dd < 4; ++dd) { const f32x4 v = o[dd] * inv; u32x2 w; w.x = cvtpk(v[0], v[1]); w.y = cvtpk(v[2], v[3]); *(u32x2*)(Qrow + 16 * dd + 4 * q4) = w; }
}

constexpr int NUNITS2 = 512 + 2048;
__device__ __forceinline__ void attn_phase(LAS unsigned char* lds, unsigned char* lds_generic, bf16_t* Qb, const bf16_t* Kb, const bf16_t* VT, const bf16_t* VC, const float* KP, const float* sinks, unsigned* ctr, bool dry = false) {
    LAS int* uw = (LAS int*)(lds + UNIT_OFF);
    for (;;) {
        if (threadIdx.x == 0) uw[0] = (int)atomicAdd(ctr, 1u);
        __syncthreads();
        const int idx = uw[0];
        __syncthreads();
        if (idx >= 512) break;
        const int qb = 7 - (idx >> 6), bh = idx & 63;
        attn_body::attn_unit<8>(bh >> 3, bh & 7, qb, (const attn_body::bf16*)(Qb + 1024), (const attn_body::bf16*)(Kb + 640), (const attn_body::bf16*)VC, (attn_body::bf16*)(Qb + 1024), (char*)lds_generic, KP);
    }
    for (;;) {
        if (threadIdx.x == 0) uw[0] = (int)atomicAdd(ctr + 16, 1u);
        __syncthreads();
        const int idx = uw[0];
        __syncthreads();
        if (idx >= 2048) break;
        if (idx < 1024) { const int qt = 15 - (idx >> 6), bh = idx & 63; attn_unit<1>(lds, Qb, Kb, VT, KP, sinks, bh >> 3, bh & 7, qt, dry); }
        else { const int ii = idx - 1024, qt = ii >> 6, bh = ii & 63; attn_unit<0>(lds, Qb, Kb, VT, KP, sinks, bh >> 3, bh & 7, qt, dry); }
    }
}
}
__device__ __forceinline__ float wave_sum(float v) {
#pragma unroll
    for (int o = 1; o < 64; o <<= 1) v += __shfl_xor(v, o);
    return v;
}
template <bool OUT_F32> __device__ __forceinline__ void rms_row(const float* xrow, const float* g, void* orow, int lane, bf16_t* hrow = nullptr) {
    const f32x4* xr = (const f32x4*)xrow + lane; const f32x4* gr = (const f32x4*)g + lane;
    f32x4 v[4]; float s = 0.f;
#pragma unroll
    for (int j = 0; j < 4; ++j) { v[j] = xr[64 * j]; s += (v[j].x * v[j].x + v[j].y * v[j].y) + (v[j].z * v[j].z + v[j].w * v[j].w); }
    const float rs = 1.0f / sqrtf(wave_sum(s) * (1.f / DM) + RMS_EPS);
#pragma unroll
    for (int j = 0; j < 4; ++j) { const f32x4 y = v[j] * rs * gr[64 * j];
        if (OUT_F32) ((f32x4*)orow)[lane + 64 * j] = y;
        else { u32x2 w; w.x = cvtpk(y.x, y.y); w.y = cvtpk(y.z, y.w); ((u32x2*)orow)[lane + 64 * j] = w; if (hrow) ((u32x2*)hrow)[lane + 64 * j] = w; } }
}
template <bool OUT_F32> __device__ __forceinline__ void rms_phase(const float* x, const float* g, void* out, int gw, int NGW, int lane, bf16_t* AH = nullptr) {
    asm volatile("" : "+v"(lane));
    for (int m = gw; m < TOK; m += NGW) { bf16_t* hrow = nullptr; if (AH && (m & 255) >= 254 && (m >> 8) < 63) hrow = AH + (size_t)(2 * ((m >> 8) + 1) + (m & 255) - 254) * DM;
        rms_row<OUT_F32>(x + (size_t)m * DM, g, OUT_F32 ? (void*)((float*)out + (size_t)m * DM) : (void*)((bf16_t*)out + (size_t)m * DM), lane, hrow); }
}
__device__ __forceinline__ int ropeperm(int c) { const int cp = c & 63; return (c & ~63) + 16 * (cp >> 5) + (cp & 15) + 32 * ((cp >> 4) & 1); }
template <int MAP> __device__ __forceinline__ int map_col(int n) {
    if (MAP == 0) return n;
    if (MAP == 1) {
        if (n < 512) return ropeperm(n);
        if (n < 1024) return 768 + (n - 512);
        if (n < 1536) return 2304 + ropeperm(n - 1024);
        if (n < 1664) return 512 + ropeperm(n - 1536);
        if (n < 1792) return 640 + (n - 1664);
        if (n < 2304) return 1280 + (n - 1792);
        if (n < 2816) return 1792 + (n - 2304);
        if (n < 3328) return 2816 + ropeperm(n - 2816);
        return 3328 + (n - 3328);
    }
    { const int pn = n >> 8, half = (n >> 7) & 1, c = 128 * pn + (n & 127); return half ? DFF + c : c; }
}
template <int MAP> __device__ __forceinline__ void transpose_job(const float* W, int ldw, int coloff, int K, int NP, bf16_t* WT, LAS float* scr, int& base, int gw, int NGW, int lane) {
    const int nblk = NP / 32, items = (K / 64) * nblk;
    int start = (gw - base) % NGW; if (start < 0) start += NGW;
    for (int it = start; it < items; it += NGW) {
        const int kb = it / nblk, nb = it % nblk, k0 = 64 * kb, n0 = 32 * nb;
        const int sc = coloff + map_col<MAP>(n0 + (lane & 31));
#pragma unroll 8
        for (int i = 0; i < 32; ++i) { const int kk = 2 * i + (lane >> 5); scr[kk * 33 + (lane & 31)] = W[(size_t)(k0 + kk) * ldw + sc]; }
        asm volatile("s_waitcnt lgkmcnt(0)" ::: "memory");
        const int c = lane & 7;
#pragma unroll
        for (int j = 0; j < 4; ++j) { const int n = (lane >> 3) + 8 * j; const LAS float* s = scr + (8 * c) * 33 + n;
            u32x4 o; o.x = cvtpk(s[0 * 33], s[1 * 33]); o.y = cvtpk(s[2 * 33], s[3 * 33]); o.z = cvtpk(s[4 * 33], s[5 * 33]); o.w = cvtpk(s[6 * 33], s[7 * 33]);
            *(u32x4*)(WT + (size_t)(n0 + n) * K + k0 + 8 * c) = o; }
        asm volatile("s_waitcnt lgkmcnt(0)" ::: "memory");
    }
    base = (base + items) % NGW;
}

__device__ __forceinline__ void xg_phase(const float* x, const float* g, bf16_t* XG, float* rss, int gw, int NGW, int lane) {
    asm volatile("" : "+v"(lane));
    for (int m = gw; m < TOK; m += NGW) {
        const f32x4* xr = (const f32x4*)(x + (size_t)m * DM) + lane; const f32x4* gr = (const f32x4*)g + lane; float s = 0.f;
#pragma unroll
        for (int j = 0; j < 4; ++j) { const f32x4 v = xr[64 * j]; s += (v.x * v.x + v.y * v.y) + (v.z * v.z + v.w * v.w); const f32x4 y = v * gr[64 * j];
            u32x2 w; w.x = cvtpk(y.x, y.y); w.y = cvtpk(y.z, y.w); ((u32x2*)(XG + (size_t)m * DM))[lane + 64 * j] = w; }
        s = wave_sum(s); if (lane == 0) rss[m] = s;
    }
}
__device__ __forceinline__ void final_phase(float* x, const float* g, const float* rss, int gw, int NGW, int lane) {
    asm volatile("" : "+v"(lane));
    for (int m = gw; m < TOK; m += NGW) { const float rsv = rs_of(rss[m]); f32x4* xr = (f32x4*)(x + (size_t)m * DM) + lane; const f32x4* gr = (const f32x4*)g + lane;
#pragma unroll
        for (int j = 0; j < 4; ++j) xr[64 * j] = xr[64 * j] * rsv * gr[64 * j]; }
}
constexpr int LDS_BYTES = 147456;
constexpr int NPH = 18;
#ifndef PHMASK
#define PHMASK 0xFFFF
#endif
#define KEN(n) (((PHMASK) >> (n)) & 1)
struct Args { const float* in[13]; float* out; unsigned char* ws; int ph_lo, ph_hi; };
static_assert(sizeof(Args) == 13 * 8 + 8 + 8 + 8, "Args has no padding");

__global__ void __launch_bounds__(NTHREADS, 2) fwd_kernel(Args a) {
    extern __shared__ __attribute__((aligned(16))) unsigned char lds_raw[];
    LAS unsigned char* lds = (LAS unsigned char*)lds_raw;
    const int tid = threadIdx.x, wave = __builtin_amdgcn_readfirstlane(tid >> 6);
#define LANE_OPAQUE() ({ int t_ = threadIdx.x; asm volatile("" : "+v"(t_)); t_ & 63; })
    const int G = gridDim.x, bx = blockIdx.x;
    const int gw = bx * NWAVES + wave, NGW = G * NWAVES, NGT = G * NTHREADS;
    unsigned char* ws = a.ws;
    const float* x_in = a.in[0]; float* xo = a.out;
    bf16_t* Hb = (bf16_t*)(ws + WS_H); bf16_t* Qb = (bf16_t*)(ws + WS_Q); bf16_t* Gb = (bf16_t*)(ws + WS_G); bf16_t* Kb = (bf16_t*)(ws + WS_K); bf16_t* VTb = (bf16_t*)(ws + WS_VT);
    float* ropeC = (float*)(ws + WS_ROPE); float* ropeS = ropeC + SEQ * 32; float* KPb = (float*)(ws + WS_KP);
    unsigned* ctl = (unsigned*)(ws + WS_CTL); float* RS = (float*)(ws + WS_RS);
    const int lo = a.ph_lo, hi = a.ph_hi;
#define RUN(k) (lo <= (k) && (k) < hi)
#if MK_ONE_LAUNCH
    volatile LAS unsigned* MISC = (volatile LAS unsigned*)(lds + 131072 + 320);
    if (tid < 32) MISC[tid] = 0u;
    __syncthreads();
    XcdBarrier bar = xcd_barrier_post(ctl + 4096, MISC + 8);
#define SEAM(k) do { if (RUN(k) && RUN((k) + 1)) { if ((k) == 0) cg::this_grid().sync(); else xcd_barrier(bar); } } while (0)
#else
#define SEAM(k) do { } while (0)
#endif

#ifdef DBL_P0
    for (int rep_ = 0; rep_ < 2; ++rep_)
#endif
    if (KEN(0) && RUN(0)) {
        LAS float* scr = (LAS float*)(lds + wave * 16384);
        int base = 0; const int lane = LANE_OPAQUE(); const int gtid = bx * NTHREADS + wave * 64 + lane;
        for (int l = 0; l < 2; ++l) {
            unsigned char* wb = ws + WS_WB + (size_t)l * WB_LAYER;
            const float* w_in = a.in[2] + (size_t)l * DM * D_IN;
            transpose_job<1>(w_in, D_IN, 0, DM, NQKV, (bf16_t*)(wb + WB_IN), scr, base, gw, NGW, lane);
            transpose_job<0>(w_in, D_IN, NQKV, DM, NGATE, (bf16_t*)(wb + WB_G), scr, base, gw, NGW, lane);
            for (int i = 0; i < 3; ++i) transpose_job<0>(a.in[5] + (size_t)(l * 3 + i) * 512 * DM, DM, 0, 512, DM, (bf16_t*)(wb + WB_BR + (size_t)i * DM * 512 * 2), scr, base, gw, NGW, lane);
            transpose_job<0>(a.in[6] + (size_t)l * DM * DM, DM, 0, DM, DM, (bf16_t*)(wb + WB_O), scr, base, gw, NGW, lane);
            transpose_job<2>(a.in[8] + (size_t)l * DM * 2 * DFF, 2 * DFF, 0, DM, 2 * DFF, (bf16_t*)(wb + WB_U), scr, base, gw, NGW, lane);
            transpose_job<0>(a.in[11] + (size_t)l * DFF * DM, DM, 0, DFF, DM, (bf16_t*)(wb + WB_D), scr, base, gw, NGW, lane);
        }
        for (int i = gtid; i < SEQ * 32; i += NGT) {
            const int t = i >> 5, f = i & 31;
            const float inv = exp2f(-(float)f * (13.287712379549449f / 32.0f));
            const float ang = (float)t * inv;
            const double rev = (double)ang * 0.15915494309189535; const float fr = (float)(rev - rint(rev));
            ropeC[i] = __builtin_amdgcn_cosf(fr); ropeS[i] = __builtin_amdgcn_sinf(fr);
        }
        xg_phase(x_in, a.in[1], Hb, RS, gw, NGW, lane);
        __syncthreads();
    }
    SEAM(0);
    for (int l = 0; l < 2; ++l) {
        const int pb = 1 + 8 * l;
        unsigned char* wb = ws + WS_WB + (size_t)l * WB_LAYER;
#ifdef DBL_PA
        for (int rep_ = 0; rep_ < 2; ++rep_)
#endif
        if (KEN(1) && RUN(pb + 0)) {
            pg8::Gemm g{Hb, (const bf16_t*)(wb + WB_IN), TOK, NQKV, DM, DM}; pg8::StaticOrder S; S.init(TOK, NQKV, G, bx);
            pg8::EpiInproj E{Qb, Kb, VTb, KPb, ropeC, ropeS, RS + (size_t)(2 * l) * TOK, (bf16_t*)(ws + WS_VC)};
            pg8::gemm_phase<pg8::EpiInproj, pg8::StaticOrder, true, true>(lds, g, S, E);
        }
        SEAM(pb + 0);
        if (KEN(2) && RUN(pb + 1)) { att::attn_phase(lds, lds_raw, Qb, Kb, VTb, (const bf16_t*)(ws + WS_VC), KPb, a.in[4] + l * 8, ctl + 64 * l); }
        SEAM(pb + 1);
        if (KEN(3) && RUN(pb + 2)) {
            pg8::Gemm g{Hb, (const bf16_t*)(wb + WB_G), TOK, NGATE, DM, DM}; pg8::StaticOrder S; S.init(TOK, NGATE, G, bx);
            pg8::EpiRowBf16<2> E{Gb, NGATE, a.in[3] + (size_t)l * NGATE, RS + (size_t)(2 * l) * TOK};
            pg8::gemm_phase<pg8::EpiRowBf16<2>, pg8::StaticOrder, true, true>(lds, g, S, E);
        }
        SEAM(pb + 2);
        if (KEN(4) && RUN(pb + 3)) {
            int first = 1;
            for (int i = 0; i < 3; ++i) {
#ifdef SKIPBR
                if (i == SKIPBR) continue;
#endif
                pg8::Gemm g{Qb + 512 * i, (const bf16_t*)(wb + WB_BR + (size_t)i * DM * 512 * 2), TOK, DM, 512, QPITCH}; pg8::StaticOrder S; S.init(TOK, DM, G, bx);
                pg8::EpiBranch E{Hb, Gb, 1024 * i, first ? 0 : 1}; first = 0;
                pg8::gemm_phase<pg8::EpiBranch, pg8::StaticOrder, true, true>(lds, g, S, E);
            }
        }
        SEAM(pb + 3);
        if (KEN(5) && RUN(pb + 4)) {
            pg8::Gemm g{Hb, (const bf16_t*)(wb + WB_O), TOK, DM, DM, DM}; pg8::StaticOrder S; S.init(TOK, DM, G, bx);
            pg8::EpiResidualNorm E{l == 0 ? x_in : (const float*)xo, xo, Qb, a.in[7] + (size_t)l * DM, RS + (size_t)(2 * l + 1) * TOK, (bf16_t*)(ws + WS_AH)};
            pg8::gemm_phase<pg8::EpiResidualNorm, pg8::StaticOrder, true, true>(lds, g, S, E);
        }
        SEAM(pb + 4);
        if (KEN(7) && RUN(pb + 5)) {
            pg8::Gemm g{(const bf16_t*)(ws + WS_AH), (const bf16_t*)(wb + WB_U), 256, 2 * DFF, DM, DM}; pg8::StaticOrder S; S.init(256, 2 * DFF, G, bx);
            pg8::EpiHalo E{(float*)(ws + WS_UH), RS + (size_t)(2 * l + 1) * TOK};
            pg8::gemm_phase<pg8::EpiHalo, pg8::StaticOrder, true, true>(lds, g, S, E);
        }
        SEAM(pb + 5);
#ifdef DBL_PG
        for (int rep_ = 0; rep_ < 2; ++rep_)
#endif
        if (KEN(8) && RUN(pb + 6)) {
            pg8::Gemm g{Qb, (const bf16_t*)(wb + WB_U), TOK, 2 * DFF, DM, DM}; pg8::StaticOrder S; S.init(TOK, 2 * DFF, G, bx);
            pg8::EpiUpConv E{Gb, (const float*)(ws + WS_UH), a.in[9] + (size_t)l * 3 * 2 * DFF, a.in[10] + (size_t)l * 2 * DFF, (LAS float*)(lds + 131072 + 1024), RS + (size_t)(2 * l + 1) * TOK};
            pg8::gemm_phase<pg8::EpiUpConv, pg8::StaticOrder, true, true>(lds, g, S, E);
        }
        SEAM(pb + 6);
        if (KEN(9) && RUN(pb + 7)) {
            pg8::Gemm g{Gb, (const bf16_t*)(wb + WB_D), TOK, DM, DFF, DFF}; pg8::StaticOrder S; S.init(TOK, DM, G, bx);
            pg8::EpiResidualNorm E{xo, xo, l == 0 ? Hb : (bf16_t*)nullptr, l == 0 ? a.in[1] + DM : (const float*)nullptr, RS + (size_t)(l == 0 ? 2 : 4) * TOK, (bf16_t*)nullptr};
            pg8::gemm_phase<pg8::EpiResidualNorm, pg8::StaticOrder, true, true>(lds, g, S, E);
        }
        SEAM(pb + 7);
    }
    if (KEN(10) && RUN(17)) { final_phase(xo, a.in[12], RS + (size_t)4 * TOK, gw, NGW, LANE_OPAQUE()); }
#undef RUN
#undef SEAM
}

extern "C" void kernel_launch(void* const* d_in, const int* in_sizes, int n_in, void* d_out, int out_size, void* d_ws, size_t ws_size, hipStream_t stream) {
    static int grid = 0;
    if (grid == 0) {
        if (n_in != 13 || in_sizes[0] != TOK * DM || out_size != TOK * DM || ws_size < WS_END) { fprintf(stderr, "kernel_launch: unexpected shapes / workspace (n_in %d, ws %zu)\n", n_in, ws_size); grid = -1; return; }
        int dev = 0, cus = 0, per_cu = 0;
        hipGetDevice(&dev); hipDeviceGetAttribute(&cus, hipDeviceAttributeMultiprocessorCount, dev);
        if (hipFuncSetAttribute((const void*)fwd_kernel, hipFuncAttributeMaxDynamicSharedMemorySize, LDS_BYTES) != hipSuccess) { fprintf(stderr, "kernel_launch: hipFuncSetAttribute failed\n"); grid = -1; return; }
        if (hipOccupancyMaxActiveBlocksPerMultiprocessor(&per_cu, (const void*)fwd_kernel, NTHREADS, LDS_BYTES) != hipSuccess || per_cu < 1) { fprintf(stderr, "kernel_launch: occupancy query gave %d\n", per_cu); per_cu = 1; }
        (void)hipGetLastError();
        grid = cus * per_cu;
    }
    if (grid < 0) return;
    hipMemsetAsync((char*)d_ws + WS_CTL, 0, CTL_BYTES, stream);
    hipMemsetAsync((char*)d_ws + WS_RS + (size_t)TOK * 4, 0, (size_t)4 * TOK * 4, stream);
    Args a{};
    for (int i = 0; i < 13; ++i) a.in[i] = (const float*)d_in[i];
    a.out = (float*)d_out; a.ws = (unsigned char*)d_ws;
#if MK_ONE_LAUNCH
    a.ph_lo = 0; a.ph_hi = NPH;
    void* args[] = {&a};
    hipError_t e = hipLaunchCooperativeKernel((const void*)fwd_kernel, dim3(grid), dim3(NTHREADS), args, LDS_BYTES, stream);
    if (e != hipSuccess) fprintf(stderr, "cooperative launch failed: %s (grid %d)\n", hipGetErrorString(e), grid);
#else
    for (int p = 0; p < NPH; ++p) { a.ph_lo = p; a.ph_hi = p + 1; hipLaunchKernelGGL(fwd_kernel, dim3(grid), dim3(NTHREADS), LDS_BYTES, stream, a); }
#endif
}
```

```cpp
#include <hip/hip_runtime.h>
#include <hip/hip_cooperative_groups.h>
#include <cstdio>
#include <cstdint>
namespace cg = cooperative_groups;
namespace pg8 {
#define PG8_LAS __attribute__((address_space(3)))
typedef unsigned short bf16_t;
typedef short bf16x8 __attribute__((ext_vector_type(8)));
typedef float f32x4 __attribute__((ext_vector_type(4)));
typedef unsigned u32x4 __attribute__((ext_vector_type(4)));
constexpr int BM = 256, BK = 64, HALF = 128, HTB = HALF * BK * 2  , STAGE_BYTES = 8 * HTB, NXCD = 8, WGM = 8;

__host__ __device__ __forceinline__ int lds_byte(int r, int c) { const int st = (r >> 4) * 2 + (c >> 5), rr = r & 15, cc = c & 31, ob = rr * 64 + cc * 2; return st * 1024 + (ob ^ (((ob >> 9) & 1) << 5)); }
__host__ __device__ __forceinline__ void stage_rc(int b, int& R, int& C) { const int st = b / 1024, sb = b % 1024, swz = sb ^ (((sb >> 9) & 1) << 5); R = (st >> 1) * 16 + swz / 64; C = (st & 1) * 32 + (swz % 64) / 2; }
__host__ __device__ __forceinline__ int perm32(int rho) { const int n = rho >> 4, i = rho & 15; return 8 * (i >> 2) + 4 * n + (i & 3); }

struct Unit { int pm, pn, br; };
struct Gemm { const bf16_t* A; const bf16_t* Bt; int M, N, K, lda; size_t abr, bbr; };

struct StaticOrder {
    int nM, nN, nwg, G, c;
    __host__ __device__ void init(int M, int N, int G_, int c_) { nM = M / BM; nN = N / BM; nwg = nM * nN; G = G_; c = c_; }
    __host__ __device__ bool next(int i, Unit& u) const {
        const long L = (long)i * G + c; if (L >= nwg) return false;
        int wgid = (int)L; { const int q = nwg / NXCD, r = nwg % NXCD, xcd = wgid % NXCD, off = wgid / NXCD; wgid = (xcd < r ? xcd * (q + 1) : r * (q + 1) + (xcd - r) * q) + off; }
        const int nig = WGM * nN, gid = wgid / nig, fm = gid * WGM, gsz = (nM - fm) < WGM ? (nM - fm) : WGM;
        u.pm = fm + ((wgid % nig) % gsz); u.pn = (wgid % nig) / gsz; u.br = 0; return true;
    }
    __device__ __forceinline__ void a_ready(const Unit&) const {}
    __device__ __forceinline__ void done(const Unit&) const {}
};

__device__ __forceinline__ unsigned cvt_pk_bf16(float lo, float hi) { unsigned r; asm volatile("v_cvt_pk_bf16_f32 %0, %1, %2" : "=v"(r) : "v"(lo), "v"(hi)); return r; }
typedef float f32x2 __attribute__((ext_vector_type(2)));

struct StaticOrder3 {
    StaticOrder base;
    __host__ __device__ void init(int M, int N, int G_, int c_) { base.init(M, N, G_, c_); }
    __host__ __device__ bool next(int j, Unit& u) const { const int i = j / 3; if (!base.next(i, u)) return false; u.br = j - 3 * i; return true; }
    __device__ __forceinline__ void a_ready(const Unit&) const {}
    __device__ __forceinline__ void done(const Unit&) const {}
};
template <class Epi, class Sched, bool ALIGN_EPI = false, bool SP2 = false>
__device__ __forceinline__ void gemm_phase(PG8_LAS unsigned char* lds, const Gemm g, const Sched& S, const Epi& E) {
    int tid_ = threadIdx.x; asm volatile("" : "+v"(tid_));
    const int tid = tid_, wid = __builtin_amdgcn_readfirstlane(tid >> 6), lane = tid & 63, wr = wid >> 2, wc = wid & 3, fr = lane & 15, fq = lane >> 4;
    const int K = g.K, nt = K / BK;
    unsigned voffA[2], voffB[2];
#pragma unroll
    for (int i = 0; i < 2; ++i) { int R, C; stage_rc(tid * 16 + i * 8192, R, C); const int Rb = Epi::PERM ? ((R & ~31) + perm32(R & 31)) : R;
        voffA[i] = (unsigned)(R * g.lda + C) * 2u; voffB[i] = (unsigned)(Rb * K + C) * 2u; }
    const size_t kstep = (size_t)(BK * 2);
    const size_t hstep = (size_t)HALF * K * 2;
    const size_t tstep = 2 * hstep; const size_t hstepA = (size_t)HALF * g.lda * 2, tstepA = 2 * hstepA;
    const unsigned ldsw = (unsigned)wid * 1024u;
    const int aoff = lds_byte(wr * 64 + fr, fq * 8), boff = lds_byte(wc * 32 + fr, fq * 8);
#define PG8_SA(b, h) (((b) * 2 + (h)) * HTB)
#define PG8_SB(b, h) ((4 + (b) * 2 + (h)) * HTB)
#define PG8_STAGE(bufoff, gbase, voff) do { _Pragma("unroll") for (int _i = 0; _i < 2; ++_i) \
        __builtin_amdgcn_global_load_lds((const unsigned*)((const char*)(gbase) + (voff)[_i]), (PG8_LAS unsigned*)(lds + (bufoff) + ldsw + _i * 8192), 16, 0, 0); } while (0)
#define PG8_LDA(dst, b, h) do { _Pragma("unroll") for (int m = 0; m < 4; ++m) _Pragma("unroll") for (int k = 0; k < 2; ++k) dst[m][k] = *(const PG8_LAS bf16x8*)(lds + PG8_SA(b, h) + aoff + m * 2048 + k * 1024); } while (0)
#define PG8_LDB(dst, b, h) do { _Pragma("unroll") for (int n = 0; n < 2; ++n) _Pragma("unroll") for (int k = 0; k < 2; ++k) dst[n][k] = *(const PG8_LAS bf16x8*)(lds + PG8_SB(b, h) + boff + n * 2048 + k * 1024); } while (0)
#define PG8_MMA(ai, bj, At, Bt) do { __builtin_amdgcn_s_setprio(1); _Pragma("unroll") for (int m = 0; m < 4; ++m) _Pragma("unroll") for (int n = 0; n < 2; ++n) _Pragma("unroll") for (int k = 0; k < 2; ++k) \
        acc[ai][bj][m][n] = __builtin_amdgcn_mfma_f32_16x16x32_bf16(Bt[n][k], At[m][k], acc[ai][bj][m][n], 0, 0, 0); __builtin_amdgcn_s_setprio(0); } while (0)
#define PG8_WAIT_V(n) asm volatile("s_waitcnt vmcnt(" #n ")" ::: "memory")
#define PG8_WAIT_L(n) asm volatile("s_waitcnt lgkmcnt(" #n ")" ::: "memory")
#define PG8_BAR __builtin_amdgcn_s_barrier()
#define PG8_SCHED __builtin_amdgcn_sched_barrier(0)
    Unit cur, nxt; int ui = 0;
    if (!S.next(0, cur)) return;
    f32x4 acc[2][2][4][2];
#pragma unroll
    for (int a = 0; a < 2; ++a)
#pragma unroll
        for (int b = 0; b < 2; ++b)
#pragma unroll
            for (int m = 0; m < 4; ++m)
#pragma unroll
                for (int n = 0; n < 2; ++n) acc[a][b][m][n] = (f32x4){0.f, 0.f, 0.f, 0.f};
    bf16x8 At[4][2], B0[2][2], B1[2][2];
    const char* cA = (const char*)g.A + (size_t)cur.br * g.abr + (size_t)cur.pm * tstepA; const char* cB = (const char*)g.Bt + (size_t)cur.br * g.bbr + (size_t)cur.pn * tstep;
    S.a_ready(cur);
    if constexpr (SP2) {
        PG8_STAGE(PG8_SB(0, 0), cB, voffB); PG8_STAGE(PG8_SB(0, 1), cB + hstep, voffB); PG8_STAGE(PG8_SA(0, 0), cA, voffA); PG8_STAGE(PG8_SA(0, 1), cA + hstepA, voffA);
        if (wr == 1) PG8_BAR;
        PG8_WAIT_V(2); PG8_BAR;
        PG8_STAGE(PG8_SB(1, 0), cB + kstep, voffB); PG8_STAGE(PG8_SA(1, 0), cA + kstep, voffA); PG8_STAGE(PG8_SB(1, 1), cB + hstep + kstep, voffB);
        PG8_WAIT_V(6); PG8_BAR;
    } else {
        PG8_STAGE(PG8_SB(0, 0), cB, voffB); PG8_STAGE(PG8_SA(0, 0), cA, voffA); PG8_STAGE(PG8_SB(0, 1), cB + hstep, voffB); PG8_STAGE(PG8_SA(0, 1), cA + hstepA, voffA);
        if (wr == 1) PG8_BAR;
        PG8_WAIT_V(4); PG8_BAR;
        PG8_STAGE(PG8_SB(1, 0), cB + kstep, voffB); PG8_STAGE(PG8_SA(1, 0), cA + kstep, voffA); PG8_STAGE(PG8_SB(1, 1), cB + hstep + kstep, voffB);
        PG8_WAIT_V(6); PG8_BAR;
    }
    for (;;) {
        const bool has_next = S.next(ui + 1, nxt);
        const char* nA = has_next ? (const char*)g.A + (size_t)nxt.br * g.abr + (size_t)nxt.pm * tstepA : cA; const char* nB = has_next ? (const char*)g.Bt + (size_t)nxt.br * g.bbr + (size_t)nxt.pn * tstep : cB;
        for (int t = 0; t < nt; t += 2) {
            const bool last = (t == nt - 2);
            const char* a1 = cA + (size_t)(t + 1) * kstep;
            const char* a2 = last ? nA : cA + (size_t)(t + 2) * kstep; const char* b2 = last ? nB : cB + (size_t)(t + 2) * kstep;
            const char* a3 = a2 + kstep; const char* b3 = b2 + kstep;
            if (last && has_next) S.a_ready(nxt);
            if constexpr (SP2) {
            PG8_LDB(B0, 0, 0); PG8_LDB(B1, 0, 1); PG8_SCHED; PG8_LDA(At, 0, 0); PG8_STAGE(PG8_SA(1, 1), a1 + hstepA, voffA);
            PG8_WAIT_V(8); PG8_WAIT_L(0); PG8_BAR; PG8_MMA(0, 0, At, B0); PG8_MMA(0, 1, At, B1); PG8_BAR; PG8_SCHED;
            PG8_LDA(At, 0, 1); PG8_STAGE(PG8_SB(0, 0), b2, voffB); PG8_STAGE(PG8_SB(0, 1), b2 + hstep, voffB); PG8_STAGE(PG8_SA(0, 0), a2, voffA);
            PG8_WAIT_V(8); PG8_WAIT_L(0); PG8_BAR; PG8_MMA(1, 0, At, B0); PG8_MMA(1, 1, At, B1); PG8_BAR; PG8_SCHED;
            PG8_LDB(B0, 1, 0); PG8_LDB(B1, 1, 1); PG8_SCHED; PG8_LDA(At, 1, 0); PG8_STAGE(PG8_SA(0, 1), a2 + hstepA, voffA);
            PG8_WAIT_V(8); PG8_WAIT_L(0); PG8_BAR; PG8_MMA(0, 0, At, B0); PG8_MMA(0, 1, At, B1); PG8_BAR; PG8_SCHED;
            PG8_LDA(At, 1, 1); PG8_STAGE(PG8_SB(1, 0), b3, voffB); PG8_STAGE(PG8_SB(1, 1), b3 + hstep, voffB); PG8_STAGE(PG8_SA(1, 0), a3, voffA);
            PG8_WAIT_V(8); PG8_WAIT_L(0); PG8_BAR; PG8_MMA(1, 0, At, B0); PG8_MMA(1, 1, At, B1); PG8_BAR; PG8_SCHED;
            } else {
            PG8_LDB(B0, 0, 0); PG8_SCHED; PG8_LDA(At, 0, 0); PG8_STAGE(PG8_SA(1, 1), a1 + hstepA, voffA);
            PG8_WAIT_L(8); PG8_BAR; PG8_WAIT_L(0); PG8_MMA(0, 0, At, B0); PG8_BAR; PG8_SCHED;
            PG8_LDB(B1, 0, 1); PG8_STAGE(PG8_SB(0, 0), b2, voffB);
            PG8_BAR; PG8_WAIT_L(0); PG8_MMA(0, 1, At, B1); PG8_BAR;
            PG8_LDA(At, 0, 1); PG8_STAGE(PG8_SA(0, 0), a2, voffA);
            PG8_BAR; PG8_WAIT_L(0); PG8_MMA(1, 0, At, B0); PG8_BAR; PG8_SCHED;
            PG8_STAGE(PG8_SB(0, 1), b2 + hstep, voffB);
            PG8_WAIT_V(6); PG8_BAR; PG8_MMA(1, 1, At, B1); PG8_BAR;
            PG8_LDB(B0, 1, 0); PG8_SCHED; PG8_LDA(At, 1, 0); PG8_STAGE(PG8_SA(0, 1), a2 + hstepA, voffA);
            PG8_WAIT_L(8); PG8_BAR; PG8_WAIT_L(0); PG8_MMA(0, 0, At, B0); PG8_BAR; PG8_SCHED;
            PG8_LDB(B1, 1, 1); PG8_STAGE(PG8_SB(1, 0), b3, voffB);
            PG8_BAR; PG8_WAIT_L(0); PG8_MMA(0, 1, At, B1); PG8_BAR;
            PG8_LDA(At, 1, 1); PG8_STAGE(PG8_SA(1, 0), a3, voffA);
            PG8_BAR; PG8_WAIT_L(0); PG8_MMA(1, 0, At, B0); PG8_BAR; PG8_SCHED;
            PG8_STAGE(PG8_SB(1, 1), b3 + hstep, voffB);
            PG8_WAIT_V(6); PG8_BAR; PG8_MMA(1, 1, At, B1); PG8_BAR;
            }
        }
        if constexpr (ALIGN_EPI) { if (wr == 0) PG8_BAR; }
        if constexpr (!Epi::AFTER_DRAIN) { E(acc, cur, wr, wc, fr, fq); S.done(cur); }
        if (!has_next) break;
#pragma unroll
        for (int a = 0; a < 2; ++a)
#pragma unroll
            for (int b = 0; b < 2; ++b)
#pragma unroll
                for (int m = 0; m < 4; ++m)
#pragma unroll
                    for (int n = 0; n < 2; ++n) acc[a][b][m][n] = (f32x4){0.f, 0.f, 0.f, 0.f};
        cur = nxt; cA = nA; cB = nB; ++ui;
        if constexpr (ALIGN_EPI) { if (wr == 1) PG8_BAR; }
    }
    PG8_WAIT_V(0);
    if constexpr (!ALIGN_EPI) { if (wr == 0) PG8_BAR; }
    PG8_BAR;
    if constexpr (Epi::AFTER_DRAIN) { E.fused(acc, cur, wr, wc, fr, fq, lds, wid, lane); S.done(cur); }
#undef PG8_SA
#undef PG8_SB
#undef PG8_STAGE
#undef PG8_LDA
#undef PG8_LDB
#undef PG8_MMA
#undef PG8_WAIT_V
#undef PG8_WAIT_L
#undef PG8_BAR
#undef PG8_SCHED
}
}

#ifndef MK_ONE_LAUNCH
#define MK_ONE_LAUNCH 1
#endif
#define LAS __attribute__((address_space(3)))
typedef unsigned short bf16_t;
typedef short bf16x8 __attribute__((ext_vector_type(8)));
typedef short s16x4 __attribute__((ext_vector_type(4)));
typedef float f32x4 __attribute__((ext_vector_type(4)));
typedef unsigned u32x4 __attribute__((ext_vector_type(4)));
typedef unsigned u32x2 __attribute__((ext_vector_type(2)));

constexpr int BATCH = 8, SEQ = 2048, DM = 1024, TOK = BATCH * SEQ;
constexpr int D_IN = 6912, NQKV = 3840, NGATE = 3072, QPITCH = 1536, KPITCH = 1152, NVH = 18;
constexpr int DFF = 2816, CW0 = 1536, CW1 = 1280;
constexpr float RMS_EPS = 1e-6f;
constexpr float LOG2E = 1.4426950408889634f;
constexpr float QSCALE = 0.125f * LOG2E;
constexpr int NWAVES = 8, NTHREADS = 512;
constexpr size_t MiB = 1u << 20;
constexpr size_t WS_CTL = 0, CTL_BYTES = 32768;
constexpr size_t WS_ROPE = 1 * MiB;
constexpr size_t WS_KP = 1 * MiB + 512 * 1024;
constexpr size_t WS_WB = 2 * MiB, WB_LAYER = 35 * MiB;
constexpr size_t WB_IN = 0, WB_G = WB_IN + (size_t)NQKV * DM * 2, WB_BR = WB_G + (size_t)NGATE * DM * 2, WB_O = WB_BR + (size_t)3 * DM * 512 * 2,
                 WB_U = WB_O + (size_t)DM * DM * 2, WB_D = WB_U + (size_t)2 * DFF * DM * 2, WB_END = WB_D + (size_t)DM * DFF * 2;
static_assert(WB_END == WB_LAYER, "weight map");
constexpr size_t WS_H = 72 * MiB;
constexpr size_t WS_Q = 104 * MiB;
constexpr size_t WS_G = 152 * MiB;
constexpr size_t WS_K = 152 * MiB;
constexpr size_t WS_VT = 188 * MiB;
constexpr size_t WS_VC = 224 * MiB;
constexpr size_t WS_AH = 248 * MiB;
constexpr size_t WS_UH = 249 * MiB;
constexpr size_t WS_RS = 32768;
constexpr size_t RS_BYTES = (size_t)5 * TOK * 4;
constexpr size_t WS_END = 252 * MiB;
static_assert(WS_RS == CTL_BYTES && WS_RS + RS_BYTES <= WS_ROPE, "control words and row sums share one memset");
__device__ __forceinline__ float rs_of(float ss) { return __builtin_amdgcn_rsqf(ss * (1.f / DM) + RMS_EPS); }

__device__ __forceinline__ float bf2f(unsigned short b) { return __uint_as_float((unsigned)b << 16); }
__device__ __forceinline__ unsigned cvtpk(float lo, float hi) { return pg8::cvt_pk_bf16(lo, hi); }
__device__ __forceinline__ float fast_exp2(float x) { return __builtin_amdgcn_exp2f(x); }
__device__ __forceinline__ float fast_log2(float x) { return __builtin_amdgcn_logf(x); }
__device__ __forceinline__ float fast_rcp(float x) { return __builtin_amdgcn_rcpf(x); }

namespace pg8 {
struct EpiInproj {
    static constexpr bool PERM = false, AFTER_DRAIN = false;
    bf16_t* Q; bf16_t* Kb; bf16_t* VT; float* KP; const float* ropeC; const float* ropeS; const float* rss; bf16_t* VC;
    __device__ __forceinline__ void operator()(const f32x4 (&acc)[2][2][4][2], const Unit& u, int wr, int wc, int fr, int fq) const {
        const int rbase = u.pm * BM + wr * 64 + fr;
#pragma unroll
        for (int bj = 0; bj < 2; ++bj) {
            const int gc0 = u.pn * BM + bj * HALF + wc * 32;
            int kind, dcol, pitch; bf16_t* dst; float sc = 1.f; int vh = 0; bool kp = false;
            if (gc0 < 1536) { dst = Q; pitch = QPITCH; dcol = gc0; sc = QSCALE; kind = (gc0 >= 512 && gc0 < 1024) ? 1 : 0; }
            else if (gc0 < 1664) { dst = Kb; pitch = KPITCH; dcol = gc0 - 1536; kind = 0; }
            else if (gc0 < 1792) { dst = VT; pitch = 0; dcol = 0; kind = 2; vh = (gc0 - 1664) >> 6; }
            else if (gc0 < 2304) { dst = Kb; pitch = KPITCH; dcol = 128 + (gc0 - 1792); kind = 1; }
            else if (gc0 < 2816) { dst = VT; pitch = 0; dcol = 0; kind = 2; vh = 2 + ((gc0 - 2304) >> 6); }
            else if (gc0 < 3328) { dst = Kb; pitch = KPITCH; dcol = 640 + (gc0 - 2816); kind = 0; kp = true; }
            else { dst = VC; pitch = 512; dcol = gc0 - 3328; kind = 1; }
            if (kind == 0) {
                const int g = (gc0 >> 5) & 1, i0 = 16 * g + 4 * fq, hc = dcol & ~63;
                f32x4 s1 = {0.f, 0.f, 0.f, 0.f}, s2 = {0.f, 0.f, 0.f, 0.f};
#pragma unroll
                for (int ai = 0; ai < 2; ++ai)
#pragma unroll
                    for (int m = 0; m < 4; ++m) {
                        const int r = rbase + ai * HALF + m * 16, t = r & (SEQ - 1);
                        const f32x4 c4 = *(const f32x4*)(ropeC + t * 32 + i0), s4 = *(const f32x4*)(ropeS + t * 32 + i0);
                        const float rsv = rs_of(rss[r]);
                        const f32x4 x1 = acc[ai][bj][m][0] * rsv, x2 = acc[ai][bj][m][1] * rsv;
                        f32x4 o1 = x1 * c4 - x2 * s4, o2 = x2 * c4 + x1 * s4;
                        s1 += o1; s2 += o2;
                        o1 = o1 * sc; o2 = o2 * sc;
                        bf16_t* p = dst + (size_t)r * pitch + hc + i0;
                        u32x2 w1, w2; w1.x = cvt_pk_bf16(o1[0], o1[1]); w1.y = cvt_pk_bf16(o1[2], o1[3]); w2.x = cvt_pk_bf16(o2[0], o2[1]); w2.y = cvt_pk_bf16(o2[2], o2[3]);
                        *(u32x2*)p = w1; *(u32x2*)(p + 32) = w2;
                    }
                if (kp) {
#pragma unroll
                    for (int j = 0; j < 4; ++j) {
#pragma unroll
                        for (int o = 1; o < 16; o <<= 1) { s1[j] += __shfl_xor(s1[j], o); s2[j] += __shfl_xor(s2[j], o); }
                    }
                    if (fr == 0) { float* kpp = KP + (size_t)(u.pm * 2 + wr) * 512 + (hc - 640) + i0; *(f32x4*)kpp = s1; *(f32x4*)(kpp + 32) = s2; }
                }
            } else if (kind == 1) {
#pragma unroll
                for (int ai = 0; ai < 2; ++ai)
#pragma unroll
                    for (int m = 0; m < 4; ++m) {
                        const int r = rbase + ai * HALF + m * 16; const float rsv = rs_of(rss[r]) * sc;
#pragma unroll
                        for (int n = 0; n < 2; ++n) { const f32x4 v = acc[ai][bj][m][n] * rsv; u32x2 w; w.x = cvt_pk_bf16(v[0], v[1]); w.y = cvt_pk_bf16(v[2], v[3]);
                            *(u32x2*)(dst + (size_t)r * pitch + dcol + 16 * n + 4 * fq) = w; }
                    }
            } else {
#pragma unroll
                for (int ai = 0; ai < 2; ++ai)
#pragma unroll
                    for (int m = 0; m < 4; ++m) {
                        const int r = rbase + ai * HALF + m * 16, b = r >> 11, t = r & (SEQ - 1); const float rsv = rs_of(rss[r]);
#pragma unroll
                        for (int n = 0; n < 2; ++n) {
                            const int d0 = (gc0 & 32) + 16 * n + 4 * fq;
                            bf16_t* p = dst + ((size_t)(b * NVH + vh) * 64 + d0) * SEQ + t;
                            const f32x4 v = acc[ai][bj][m][n] * rsv;
                            const unsigned w0 = cvt_pk_bf16(v[0], v[1]), w1 = cvt_pk_bf16(v[2], v[3]);
                            p[0] = (bf16_t)(w0 & 0xffffu); p[SEQ] = (bf16_t)(w0 >> 16); p[2 * SEQ] = (bf16_t)(w1 & 0xffffu); p[3 * SEQ] = (bf16_t)(w1 >> 16);
                        }
                    }
            }
        }
    }
};
template <int ACT> struct EpiRowBf16 {
    static constexpr bool PERM = false, AFTER_DRAIN = false;
    bf16_t* O; int ldc; const float* bias; const float* rss;
    __device__ __forceinline__ void operator()(const f32x4 (&acc)[2][2][4][2], const Unit& u, int wr, int wc, int fr, int fq) const {
        const int row0 = u.pm * BM + wr * 64 + fr, col0 = u.pn * BM + wc * 32 + 4 * fq;
        f32x4 bv[2][2];
#pragma unroll
        for (int bj = 0; bj < 2; ++bj)
#pragma unroll
            for (int n = 0; n < 2; ++n) bv[bj][n] = bias ? *(const f32x4*)(bias + col0 + bj * HALF + 16 * n) : (f32x4){0.f, 0.f, 0.f, 0.f};
#pragma unroll
        for (int ai = 0; ai < 2; ++ai)
#pragma unroll
            for (int m = 0; m < 4; ++m) { bf16_t* rowp = O + (size_t)(row0 + ai * HALF + m * 16) * ldc + col0; const float rsv = rs_of(rss[row0 + ai * HALF + m * 16]);
#pragma unroll
                for (int bj = 0; bj < 2; ++bj)
#pragma unroll
                    for (int n = 0; n < 2; ++n) { f32x4 v0 = acc[ai][bj][m][n] * rsv + bv[bj][n];
                        if (ACT == 2) {
#pragma unroll
                            for (int j = 0; j < 4; ++j) v0[j] = __builtin_amdgcn_rcpf(1.f + __builtin_amdgcn_exp2f(-LOG2E * v0[j]));
                        }
                        u32x2 w; w.x = cvt_pk_bf16(v0[0], v0[1]); w.y = cvt_pk_bf16(v0[2], v0[3]);
                        *(u32x2*)(rowp + bj * HALF + 16 * n) = w; } }
    }
};
struct EpiBranch {
    static constexpr bool PERM = false, AFTER_DRAIN = false;
    bf16_t* Mo; const bf16_t* G;
    __device__ __forceinline__ void operator()(const f32x4 (&acc)[2][2][4][2], const Unit& u, int wr, int wc, int fr, int fq) const {
        const int row0 = u.pm * BM + wr * 64 + fr, col0 = u.pn * BM + wc * 32 + 4 * fq; const int goff = 1024 * u.br, accum = u.br;
#pragma unroll
        for (int ai = 0; ai < 2; ++ai)
#pragma unroll
            for (int m = 0; m < 4; ++m) { const size_t r = (size_t)(row0 + ai * HALF + m * 16);
#pragma unroll
                for (int bj = 0; bj < 2; ++bj)
#pragma unroll
                    for (int n = 0; n < 2; ++n) {
                        const int c = col0 + bj * HALF + 16 * n;
                        const u32x2 gv = *(const u32x2*)(G + r * NGATE + goff + c);
                        u32x2 mv = {0u, 0u}; if (accum) mv = *(const u32x2*)(Mo + r * DM + c);
                        const f32x4 a0 = acc[ai][bj][m][n];
                        float o[4];
#pragma unroll
                        for (int k = 0; k < 2; ++k) {
                            const unsigned gw = gv[k], mw = mv[k];
                            o[2 * k] = __uint_as_float(mw << 16) + __uint_as_float(gw << 16) * a0[2 * k];
                            o[2 * k + 1] = __uint_as_float(mw & 0xffff0000u) + __uint_as_float(gw & 0xffff0000u) * a0[2 * k + 1];
                        }
                        u32x2 w; w.x = cvt_pk_bf16(o[0], o[1]); w.y = cvt_pk_bf16(o[2], o[3]);
                        *(u32x2*)(Mo + r * DM + c) = w; } }
    }
};
struct EpiResidual {
    static constexpr bool PERM = false, AFTER_DRAIN = false;
    const float* base; float* out;
    __device__ __forceinline__ void operator()(const f32x4 (&acc)[2][2][4][2], const Unit& u, int wr, int wc, int fr, int fq) const {
        const int col0 = u.pn * BM + wc * 32 + 4 * fq;
#pragma unroll
        for (int ai = 0; ai < 2; ++ai)
#pragma unroll
            for (int m = 0; m < 4; ++m) { const size_t off = (size_t)(u.pm * BM + ai * HALF + wr * 64 + m * 16 + fr) * DM + col0;
#pragma unroll
                for (int bj = 0; bj < 2; ++bj)
#pragma unroll
                    for (int n = 0; n < 2; ++n) { const f32x4 bs = *(const f32x4*)(base + off + bj * HALF + n * 16); *(f32x4*)(out + off + bj * HALF + n * 16) = bs + acc[ai][bj][m][n]; } }
    }
};

struct EpiHalo {
    static constexpr bool PERM = false, AFTER_DRAIN = false;
    float* UH; const float* rss;
    __device__ __forceinline__ void operator()(const f32x4 (&acc)[2][2][4][2], const Unit& u, int wr, int wc, int fr, int fq) const {
        const int col0 = u.pn * BM + wc * 32 + 4 * fq;
#pragma unroll
        for (int m = 0; m < 4; ++m) { const int rho = wr * 64 + m * 16 + fr; const size_t off = (size_t)rho * (2 * DFF) + col0;
            int tok = 256 * (rho >> 1) - 2 + (rho & 1); if (tok < 0) tok = 0; const float rsv = rs_of(rss[tok]);
#pragma unroll
            for (int bj = 0; bj < 2; ++bj)
#pragma unroll
                for (int n = 0; n < 2; ++n) *(f32x4*)(UH + off + bj * HALF + n * 16) = acc[0][bj][m][n] * rsv; }
    }
};
struct EpiUpConv {
    static constexpr bool PERM = false, AFTER_DRAIN = false;
    bf16_t* ACT; const float* UH; const float* cw; const float* cb; LAS float* X; const float* rss;
    __device__ __forceinline__ void operator()(const f32x4 (&acc)[2][2][4][2], const Unit& u, int wr, int wc, int fr, int fq) const {
        const int cl = wc * 32 + 4 * fq;
        const float* rsp = rss + u.pm * BM + wr * 64 + fr;
        if (fr >= 14) {
            float rsr[2][4];
#pragma unroll
            for (int ai = 0; ai < 2; ++ai) rsr[ai][3] = rs_of(rsp[ai * HALF + 48]);
#pragma unroll
            for (int ai = 0; ai < 2; ++ai)
#pragma unroll
                for (int bj = 0; bj < 2; ++bj)
#pragma unroll
                    for (int n = 0; n < 2; ++n) *(LAS f32x4*)(X + ((ai * 2 + wr) * 2 + (fr - 14)) * 256 + bj * HALF + cl + 16 * n) = acc[ai][bj][3][n] * rsr[ai][3];
        }
        asm volatile("s_waitcnt lgkmcnt(0)\n\ts_barrier" ::: "memory");
        const bool seqstart = (u.pm & 7) == 0;
#define ROR1(x) __uint_as_float((unsigned)__builtin_amdgcn_update_dpp(0, (int)__float_as_uint(x), 0x121, 0xF, 0xF, false))
#define ROR2(x) __uint_as_float((unsigned)__builtin_amdgcn_update_dpp(0, (int)__float_as_uint(x), 0x122, 0xF, 0xF, false))
#pragma unroll
        for (int n = 0; n < 2; ++n) {
            const int ch = u.pn * HALF + cl + 16 * n;
            const f32x4 wa0 = *(const f32x4*)(cw + ch), wa1 = *(const f32x4*)(cw + 2 * DFF + ch), wa2 = *(const f32x4*)(cw + 4 * DFF + ch);
            const f32x4 wv0 = *(const f32x4*)(cw + DFF + ch), wv1 = *(const f32x4*)(cw + 3 * DFF + ch), wv2 = *(const f32x4*)(cw + 5 * DFF + ch);
            const f32x4 ba = *(const f32x4*)(cb + ch), bv = *(const f32x4*)(cb + DFF + ch);
#pragma unroll
            for (int ai = 0; ai < 2; ++ai) {
                const int blk = ai * 2 + wr;
                f32x4 Ba1 = {0.f, 0.f, 0.f, 0.f}, Ba2 = Ba1, Bv1 = Ba1, Bv2 = Ba1;
                if (blk > 0) { const LAS float* xp = X + (blk - 1) * 512 + cl + 16 * n;
                    Ba2 = *(const LAS f32x4*)xp; Ba1 = *(const LAS f32x4*)(xp + 256); Bv2 = *(const LAS f32x4*)(xp + HALF); Bv1 = *(const LAS f32x4*)(xp + 256 + HALF); }
                else if (!seqstart) { const float* hp = UH + (size_t)(2 * u.pm) * (2 * DFF) + u.pn * BM + cl + 16 * n;
                    Ba2 = *(const f32x4*)hp; Ba1 = *(const f32x4*)(hp + 2 * DFF); Bv2 = *(const f32x4*)(hp + HALF); Bv1 = *(const f32x4*)(hp + 2 * DFF + HALF); }
                f32x4 pa1 = Ba1, pa2 = (fr == 0) ? Ba2 : Ba1, pv1 = Bv1, pv2 = (fr == 0) ? Bv2 : Bv1;
#pragma unroll
                for (int m = 0; m < 4; ++m) {
                    const float rsv = rs_of(rsp[ai * HALF + m * 16]);
                    f32x4 ca;
                    { const f32x4 ca0 = acc[ai][0][m][n] * rsv; f32x4 sa1, sa2;
#pragma unroll
                      for (int j = 0; j < 4; ++j) { sa1[j] = ROR1(ca0[j]); sa2[j] = ROR2(ca0[j]); }
                      const f32x4 a1 = (fr >= 1) ? sa1 : pa1, a2 = (fr >= 2) ? sa2 : pa2;
                      ca = ba + wa0 * a2 + wa1 * a1 + wa2 * ca0; pa1 = sa1; pa2 = sa2;
#pragma unroll
                      for (int j = 0; j < 4; ++j) ca[j] = ca[j] * __builtin_amdgcn_rcpf(1.f + __builtin_amdgcn_exp2f(-LOG2E * ca[j])); }

                    { const f32x4 cv0 = acc[ai][1][m][n] * rsv; f32x4 sv1, sv2;
#pragma unroll
                      for (int j = 0; j < 4; ++j) { sv1[j] = ROR1(cv0[j]); sv2[j] = ROR2(cv0[j]); }
                      const f32x4 v1 = (fr >= 1) ? sv1 : pv1, v2 = (fr >= 2) ? sv2 : pv2;
                      const f32x4 cv = bv + wv0 * v2 + wv1 * v1 + wv2 * cv0; pv1 = sv1; pv2 = sv2;
                      const f32x4 o = ca * cv;
                      u32x2 w; w.x = cvt_pk_bf16(o[0], o[1]); w.y = cvt_pk_bf16(o[2], o[3]);
                      *(u32x2*)(ACT + (size_t)(u.pm * BM + ai * HALF + wr * 64 + m * 16 + fr) * DFF + ch) = w; }
                    asm volatile("" ::: "memory");
                }
            }
        }
    }
};
struct EpiResidualNorm {
    static constexpr bool PERM = false, AFTER_DRAIN = false;
    const float* base; float* out; bf16_t* XG; const float* g; float* rss; bf16_t* AH;
    __device__ __forceinline__ void operator()(const f32x4 (&acc)[2][2][4][2], const Unit& u, int wr, int wc, int fr, int fq) const {
        const int col0 = u.pn * BM + wc * 32 + 4 * fq;
        f32x4 gv[2][2];
#pragma unroll
        for (int bj = 0; bj < 2; ++bj)
#pragma unroll
            for (int n = 0; n < 2; ++n) gv[bj][n] = g ? *(const f32x4*)(g + col0 + bj * HALF + n * 16) : (f32x4){0.f, 0.f, 0.f, 0.f};
#pragma unroll
        for (int ai = 0; ai < 2; ++ai)
#pragma unroll
            for (int m = 0; m < 4; ++m) { const int r = u.pm * BM + ai * HALF + wr * 64 + m * 16 + fr; const size_t off = (size_t)r * DM + col0;
                bf16_t* hrow = nullptr; if (AH && (r & 255) >= 254 && (r >> 8) < 63) hrow = AH + (size_t)(2 * ((r >> 8) + 1) + (r & 255) - 254) * DM + col0;
                float ss = 0.f;
#pragma unroll
                for (int bj = 0; bj < 2; ++bj)
#pragma unroll
                    for (int n = 0; n < 2; ++n) { const f32x4 bs = *(const f32x4*)(base + off + bj * HALF + n * 16); const f32x4 xn = bs + acc[ai][bj][m][n];
                        *(f32x4*)(out + off + bj * HALF + n * 16) = xn;
                        ss += (xn[0] * xn[0] + xn[1] * xn[1]) + (xn[2] * xn[2] + xn[3] * xn[3]);
                        if (XG) { const f32x4 y = xn * gv[bj][n]; u32x2 w; w.x = cvt_pk_bf16(y[0], y[1]); w.y = cvt_pk_bf16(y[2], y[3]);
                            *(u32x2*)(XG + off + bj * HALF + n * 16) = w; if (hrow) *(u32x2*)(hrow + bj * HALF + n * 16) = w; } }
                ss += __shfl_xor(ss, 16); ss += __shfl_xor(ss, 32);
                if (fq == 0) atomicAdd(rss + r, ss);
            }
    }
};
}
#define XB_TMO      128
#define XB_XCNT(j)  (256  + 64 * (j))
#define XB_XSUB(j)  (1280 + 64 * (j))
#define XB_XGEN(j)  (2304 + 64 * (j))
#define XB_TOP      3328
#define XB_TOPGEN   3392
#define XCD_BAR_WORDS 3456
#define XB_SPIN_CAP (1u << 18)

__device__ __forceinline__ unsigned xb_ld(unsigned* p)              { return __hip_atomic_load(p, __ATOMIC_RELAXED, __HIP_MEMORY_SCOPE_AGENT); }
__device__ __forceinline__ unsigned xb_add(unsigned* p, unsigned v) { return __hip_atomic_fetch_add(p, v, __ATOMIC_RELAXED, __HIP_MEMORY_SCOPE_AGENT); }
__device__ __forceinline__ unsigned xb_xcc_id() { return (unsigned)__builtin_amdgcn_s_getreg((3 << 11) | 20) & 0xFu; }
#define XB_SPIN(cond, bar) do { unsigned _sp = 0; while (cond) { __builtin_amdgcn_s_sleep(1); \
    if ((++_sp & 255u) == 0u) { if (xb_ld(&(bar)[XB_TMO])) break; if (_sp > XB_SPIN_CAP) { atomicAdd(&(bar)[XB_TMO], 1u); break; } } } } while (0)

struct XcdBarrier {
    unsigned* bar; unsigned x;
    volatile LAS unsigned* st;
};

__device__ __forceinline__ XcdBarrier xcd_barrier_post(unsigned* bar, volatile LAS unsigned* st) {
    XcdBarrier b; b.bar = bar; b.x = xb_xcc_id(); b.st = st;
    if (threadIdx.x == 0) (void)xb_add(&bar[XB_XCNT(b.x)], 1u);
    return b;
}
__device__ __forceinline__ void xcd_barrier_complete(unsigned* bar, unsigned x, unsigned& nloc, unsigned& nx) {
    const unsigned G = gridDim.x * gridDim.y * gridDim.z;
    unsigned sum, cnt, mine, sp = 0u;
    for (;;) {
        sum = 0u; cnt = 0u; mine = 0u;
#pragma unroll
        for (unsigned j = 0; j < 16; ++j) { const unsigned c = xb_ld(&bar[XB_XCNT(j)]); sum += c; cnt += (c > 0u) ? 1u : 0u; mine = (j == x) ? c : mine; }
        if (sum == G) break;
        __builtin_amdgcn_s_sleep(1);
        if ((++sp & 255u) == 0u) { if (xb_ld(&bar[XB_TMO])) break; if (sp > XB_SPIN_CAP) { atomicAdd(&bar[XB_TMO], 1u); break; } }
    }
    nloc = mine > 0u ? mine : 1u; nx = cnt > 0u ? cnt : 1u;
}

__device__ __forceinline__ void xcd_barrier(const XcdBarrier& b) {
    asm volatile("s_waitcnt vmcnt(0)" ::: "memory");
    __syncthreads();
    if (threadIdx.x == 0) {
        unsigned* bar = b.bar;
        __builtin_amdgcn_s_waitcnt(0);
        unsigned nloc = b.st[0], nx = b.st[1];
        if (nloc == 0u) { xcd_barrier_complete(bar, b.x, nloc, nx); b.st[0] = nloc; b.st[1] = nx; }
        const unsigned old = xb_add(&bar[XB_XSUB(b.x)], 1u);
        const unsigned gen = old / nloc;
        if (old + 1u == (gen + 1u) * nloc) {
            __builtin_amdgcn_fence(__ATOMIC_RELEASE, "agent");
            asm volatile("s_waitcnt vmcnt(0)" ::: "memory");
            const unsigned og = xb_add(&bar[XB_TOP], 1u);
            const unsigned tg = og / nx;
            if (og + 1u == (tg + 1u) * nx) xb_add(&bar[XB_TOPGEN], 1u);
            else XB_SPIN(xb_ld(&bar[XB_TOPGEN]) == tg, bar);
            __builtin_amdgcn_fence(__ATOMIC_ACQUIRE, "agent");
            xb_add(&bar[XB_XGEN(b.x)], 1u);
            asm volatile("s_waitcnt vmcnt(0)" ::: "memory");
        } else {
            XB_SPIN(xb_ld(&bar[XB_XGEN(b.x)]) == gen, bar);
            __builtin_amdgcn_fence(__ATOMIC_ACQUIRE, "agent");
            asm volatile("s_waitcnt vmcnt(0)" ::: "memory");
        }
    }
    __syncthreads();
}
#include <hip/hip_bf16.h>
#include <cmath>
namespace attn_body {
using bf16=__hip_bfloat16;
using bf16x8=__attribute__((ext_vector_type(8)))short;
using s16x4=__attribute__((ext_vector_type(4)))short;
using f32x16=__attribute__((ext_vector_type(16)))float;
using u32x4=__attribute__((ext_vector_type(4)))unsigned;
constexpr int BATCH=8,NHEAD=8,SEQ=2048,D=64,QPT=1536,KPT=1152,VPT=512;
constexpr int NW=8,QBLK=32,QB=QBLK*NW,KVBLK=64,NQB=SEQ/QB;
constexpr int ATTN_UNIT_ROWS=QB;
__device__ __forceinline__ int crow(int r,int hi){return (r&3)+8*(r>>2)+4*hi;}
#define SBAR() __builtin_amdgcn_sched_barrier(0)
__device__ __forceinline__ void cmask(f32x16&p0,f32x16&p1,int jb,int qrel,int hi){
  const float NEG=-INFINITY; int kb=64*jb+4*hi;
  #pragma unroll
  for(int r=0;r<16;++r){int kv=kb+(r&3)+8*(r>>2); if(kv>qrel)p0[r]=NEG; if(kv+32>qrel)p1[r]=NEG;}
}

constexpr int NSLOT=3, SLOTB=8192;
constexpr int LDS_K=0, LDS_V=NSLOT*SLOTB, LDS_WS=2*NSLOT*SLOTB, LDS_OST=LDS_WS+NW*64*4, LDS_BYTES=LDS_OST+NW*4096;
constexpr float C2=0.125f*1.4426950408889634f;
__device__ __forceinline__ void glds16(const void*gsrc,unsigned lds_dst){unsigned keep;
  asm volatile("s_mov_b32 %0, m0\n\ts_mov_b32 m0, %2\n\ts_nop 0\n\tglobal_load_lds_dwordx4 %1, off\n\ts_mov_b32 m0, %0":"=&s"(keep):"v"(gsrc),"s"(lds_dst):"memory");}
__device__ __forceinline__ float max3f(float a,float b,float c){float r;asm("v_max3_f32 %0, %1, %2, %3":"=v"(r):"v"(a),"v"(b),"v"(c));return r;}
__device__ __forceinline__ float max2f(float a,float b){float r;asm("v_max_f32_e32 %0, %1, %2":"=v"(r):"v"(a),"v"(b));return r;}
__device__ __forceinline__ float fadd_s(float a,float b){float r;asm("v_add_f32_e32 %0, %1, %2":"=v"(r):"v"(a),"v"(b));return r;}
__device__ __forceinline__ float fsub_s(float a,float b){float r;asm("v_sub_f32_e32 %0, %1, %2":"=v"(r):"v"(a),"v"(b));return r;}
typedef float f32x2_t __attribute__((ext_vector_type(2))); typedef __bf16 bf16x2_t __attribute__((ext_vector_type(2)));
__device__ __forceinline__ unsigned cvtpk_s(float lo,float hi){f32x2_t v={lo,hi};bf16x2_t b=__builtin_convertvector(v,bf16x2_t);return __builtin_bit_cast(unsigned,b);}
#define WAIT_BAR(N) asm volatile("s_waitcnt vmcnt(" #N ") lgkmcnt(0)\n\ts_barrier":::"memory")

__device__ __forceinline__ void qkt(f32x16&p0,f32x16&p1,const char*Kslot,const bf16x8*qr,const f32x16&negm,int r32,int hi){
  const char*kb=Kslot+hi*1024+r32*16;
  #pragma unroll
  for(int d0=0;d0<4;++d0){
    const bf16x8 b0=*reinterpret_cast<const bf16x8*>(kb+d0*2048);
    const bf16x8 b1=*reinterpret_cast<const bf16x8*>(kb+d0*2048+512);
    if(d0==0){p0=__builtin_amdgcn_mfma_f32_32x32x16_bf16(b0,qr[0],negm,0,0,0);p1=__builtin_amdgcn_mfma_f32_32x32x16_bf16(b1,qr[0],negm,0,0,0);}
    else{p0=__builtin_amdgcn_mfma_f32_32x32x16_bf16(b0,qr[d0],p0,0,0,0);p1=__builtin_amdgcn_mfma_f32_32x32x16_bf16(b1,qr[d0],p1,0,0,0);}}
}
typedef __attribute__((address_space(3))) const char* lds_cptr;
typedef short v4i16_t __attribute__((ext_vector_type(4)));
__device__ __forceinline__ void kload8(bf16x8*kf,lds_cptr kp){
  kf[0]=*(const __attribute__((address_space(3))) bf16x8*)(kp);      kf[1]=*(const __attribute__((address_space(3))) bf16x8*)(kp+512);
  kf[2]=*(const __attribute__((address_space(3))) bf16x8*)(kp+2048); kf[3]=*(const __attribute__((address_space(3))) bf16x8*)(kp+2560);
  kf[4]=*(const __attribute__((address_space(3))) bf16x8*)(kp+4096); kf[5]=*(const __attribute__((address_space(3))) bf16x8*)(kp+4608);
  kf[6]=*(const __attribute__((address_space(3))) bf16x8*)(kp+6144); kf[7]=*(const __attribute__((address_space(3))) bf16x8*)(kp+6656);
}
__device__ __forceinline__ void kload2(bf16x8*kf,lds_cptr kp,int j){ kf[2*j]=*(const __attribute__((address_space(3))) bf16x8*)(kp+j*2048); kf[2*j+1]=*(const __attribute__((address_space(3))) bf16x8*)(kp+j*2048+512); }
__device__ __forceinline__ s16x4 vtr(lds_cptr p){ return __builtin_bit_cast(s16x4,__builtin_amdgcn_ds_read_tr16_b64_v4i16((__attribute__((address_space(3))) v4i16_t*)p)); }
__device__ __forceinline__ float rowmax(const f32x16&p0,const f32x16&p1){
  float a=max3f(p0[0],p0[1],p1[0]),b=max3f(p0[2],p0[3],p1[1]);a=max3f(a,p1[2],p1[3]);
  #pragma unroll
  for(int r=4;r<16;r+=4){a=max3f(a,p0[r],p0[r+1]);b=max3f(b,p0[r+2],p0[r+3]);a=max3f(a,p1[r],p1[r+1]);b=max3f(b,p1[r+2],p1[r+3]);}
  const float m=max2f(a,b);
  auto rr=__builtin_amdgcn_permlane32_swap(__float_as_uint(m),__float_as_uint(m),false,false);
  return max2f(__uint_as_float(rr[0]),__uint_as_float(rr[1]));
}
__device__ __forceinline__ void pv(f32x16*o,int vb,bf16x8 pa0,bf16x8 pa1,bf16x8 pa2,bf16x8 pa3){
  #pragma unroll
  for(int d0=0;d0<2;++d0){s16x4 lo[4],hi[4];
    #pragma unroll
    for(int ks=0;ks<4;++ks){
      asm volatile("ds_read_b64_tr_b16 %0,%1 offset:%c2":"=&v"(lo[ks]):"v"(vb),"i"(d0*4096+ks*1024):"memory");
      asm volatile("ds_read_b64_tr_b16 %0,%1 offset:%c2":"=&v"(hi[ks]):"v"(vb),"i"(d0*4096+ks*1024+512):"memory");}
    asm volatile("s_waitcnt lgkmcnt(0)":::"memory");SBAR();
    #define PK(k) (bf16x8){lo[k][0],lo[k][1],lo[k][2],lo[k][3],hi[k][0],hi[k][1],hi[k][2],hi[k][3]}
    o[d0]=__builtin_amdgcn_mfma_f32_32x32x16_bf16(pa0,PK(0),o[d0],0,0,0);
    o[d0]=__builtin_amdgcn_mfma_f32_32x32x16_bf16(pa1,PK(1),o[d0],0,0,0);
    o[d0]=__builtin_amdgcn_mfma_f32_32x32x16_bf16(pa2,PK(2),o[d0],0,0,0);
    o[d0]=__builtin_amdgcn_mfma_f32_32x32x16_bf16(pa3,PK(3),o[d0],0,0,0);
    #undef PK
  }
}

#ifndef ATTN_STORE16
#define ATTN_STORE16(p,v) (*(u32x4*)(p)=(v))
#endif
template<int THRL> __device__ __forceinline__ void attn_unit(int b,int h,int qb,const bf16*Q,const bf16*__restrict__ K,const bf16*__restrict__ V,bf16*O,char*shm,const float*KP){
  int tid_=threadIdx.x; asm volatile("":"+v"(tid_));
  const int tid=tid_,lane=tid&63,r32=lane&31,hi=lane>>5; const int wid=__builtin_amdgcn_readfirstlane(tid>>6);
  const long rowbase=(long)b*SEQ; const int q0=qb*QB;
  const bf16*Qw=Q+(rowbase+q0+wid*QBLK)*QPT+h*D;
  const bf16*Kh=K+rowbase*KPT+h*D,*Vh=V+rowbase*VPT+h*D;
  const unsigned lds0=(unsigned)(uintptr_t)shm;
  float*wsf=(float*)(shm+LDS_WS)+wid*64;
  const bf16*ksrc=Kh+(long)lane*KPT+wid*8;
  const bf16*vsrc=Vh+(long)(16*(wid&3)+(lane>>2))*VPT+(wid>>2)*32+(lane&3)*8;
  const unsigned kdst=lds0+LDS_K+wid*1024, vdst=lds0+LDS_V+wid*1024;
  #define DMA_K(t,slot) glds16(ksrc+(long)(t)*KVBLK*KPT,(unsigned)__builtin_amdgcn_readfirstlane(kdst+(slot)))
  #define DMA_V(t,slot) glds16(vsrc+(long)(t)*KVBLK*VPT,(unsigned)__builtin_amdgcn_readfirstlane(vdst+(slot)))
  const int vb0=(int)(lds0+LDS_V)+((lane>>4)&1)*32+(lane&3)*8+(4*hi+((lane&15)>>2))*64;
  const char*Kbase=shm+LDS_K; bf16x8 kf[8];
  const lds_cptr shm3=(lds_cptr)shm; const lds_cptr kp0=shm3+LDS_K+hi*1024+r32*16; const lds_cptr vp0=shm3+LDS_V+((lane>>4)&1)*32+(lane&3)*8+(4*hi+((lane&15)>>2))*64;
  const int NT=(q0+QB)/KVBLK;
  unsigned sel=0u; const bool domask=(qb>3);
  if(domask){
    float*km=(float*)(shm+86016);
    { const int n=tid>>6,d=tid&63; float v=0.f; if(n<qb){ const float*p=KP+(size_t)((b*8+n)*2)*512+h*64+d; v=p[0]+p[512]; } km[n*64+d]=v; }
    __syncthreads();
    float g4[4]={0.f,0.f,0.f,0.f};
    #pragma unroll
    for(int k=0;k<8;++k){ const bf16x8 qv=*reinterpret_cast<const bf16x8*>(&Qw[(long)r32*QPT+8*k]);
      #pragma unroll
      for(int e=0;e<8;++e){ const float qe=__uint_as_float(((unsigned)(unsigned short)qv[e])<<16);
        #pragma unroll
        for(int n4=0;n4<4;++n4) g4[n4]+=qe*km[(hi*4+n4)*64+8*k+e]; } }
    float g[8];
    #pragma unroll
    for(int n4=0;n4<4;++n4){ const float go=__shfl(g4[n4],lane^32); g[n4]=hi?go:g4[n4]; g[4+n4]=hi?g4[n4]:go; }
    #pragma unroll
    for(int n=0;n<8;++n){ int cnt=0;
      #pragma unroll
      for(int n2=0;n2<8;++n2) if(n2!=n) cnt+=(n2<qb&&((g[n2]>g[n])||(g[n2]==g[n]&&n2<n)))?1:0;
      if(n<qb&&cnt<3) sel|=(1u<<n); }
    __syncthreads();
  }
  DMA_K(0,0);DMA_V(0,0);DMA_K(1,SLOTB);
  bf16x8 qr[4];
  #pragma unroll
  for(int d0=0;d0<4;++d0)qr[d0]=*reinterpret_cast<const bf16x8*>(&Qw[(long)r32*QPT+d0*16+hi*8]);
  float mhat=0.f,l_reg=0.f;f32x16 o[2];o[0]=f32x16{};o[1]=f32x16{};f32x16 negm=f32x16{};asm volatile("":"+v"(negm));
  const int qrel=wid*QBLK+r32;
  #define CMASK(P0,P1,t) do{int jb_=(t)-(NT-4); if(jb_>=0)cmask(P0,P1,jb_,qrel,hi); else if(domask){ if(!((sel>>((t)>>2))&1u)){ _Pragma("unroll") for(int r_=0;r_<16;++r_){P0[r_]=-1e30f;P1[r_]=-1e30f;} } } }while(0)
  bool resc=false;
  #define START(P0,P1) do{ const float rm=rowmax(P0,P1); resc=false; \
    { const float dl=__builtin_fmaxf(rm,-30000.f); mhat=fadd_s(mhat,dl); \
      _Pragma("unroll") for(int r=0;r<16;++r){P0[r]=fsub_s(P0[r],dl);P1[r]=fsub_s(P1[r],dl);} \
      _Pragma("unroll") for(int r=0;r<16;++r)negm[r]=-mhat; asm volatile("":"+v"(negm)); } \
    _Pragma("unroll") for(int r=0;r<16;++r)P0[r]=__builtin_amdgcn_exp2f(P0[r]); }while(0)
  #define RESC() do{ if(resc){ asm volatile("s_waitcnt lgkmcnt(0)":::"memory"); \
      _Pragma("unroll") for(int d_=0;d_<2;++d_) _Pragma("unroll") for(int r=0;r<16;++r)o[d_][r]*=wsf[crow(r,hi)]; } }while(0)
  f32x16 pA0,pA1,pB0,pB1;
  int sl_prev=0,sl_cur=0,sl_next=SLOTB;
  #define ROT() do{sl_prev=sl_cur;sl_cur=sl_next;sl_next=(sl_next==(NSLOT-1)*SLOTB)?0:sl_next+SLOTB;}while(0)
  DMA_K(2,2*SLOTB);
  WAIT_BAR(3);
  qkt(pA0,pA1,Kbase,qr,negm,r32,hi);asm volatile("s_nop 15\n\ts_nop 7":"+v"(pA0),"+v"(pA1));CMASK(pA0,pA1,0);
  START(pA0,pA1);
  _Pragma("unroll") for(int r=0;r<16;++r)pA1[r]=__builtin_amdgcn_exp2f(pA1[r]);
  WAIT_BAR(0);
  DMA_K(3,0);DMA_V(1,SLOTB);
  ROT();
  kload8(kf,kp0+sl_cur);
  WAIT_BAR(2);
  s16x4 vlo[8],vhi[8]; u32x4 pw0,pw1,pw2,pw3;
  #define PKW(P,B) cvtpk_s(P[B],P[B+1])
  #define PAF(k) __builtin_bit_cast(bf16x8,pw##k)
  #define VFR(i) (bf16x8){vlo[i][0],vlo[i][1],vlo[i][2],vlo[i][3],vhi[i][0],vhi[i][1],vhi[i][2],vhi[i][3]}
  #define PIN(x) asm volatile("":"+v"(x))
  #define MX3(a,b,c) __builtin_fmaxf(__builtin_fmaxf((a),(b)),(c))
  #define GAPA(MF,A0,A1,A2,A3,W0,W1,PW) do{ MF; sacc+=A0; sacc+=A1; sacc+=A2; sacc+=A3; PIN(sacc); W0; W1; PIN(PW); SBAR(); }while(0)
  #define EX(v) __builtin_amdgcn_exp2f(v)
  #define GAPB(MF,X,B) do{ MF; X[B]=EX(X[B]); X[B+1]=EX(X[B+1]); X[B+2]=EX(X[B+2]); X[B+3]=EX(X[B+3]); PIN(X); SBAR(); }while(0)
  #define VRD(i) do{ vlo[i]=vtr(vp_+(((i)>>2)*4096+((i)&3)*1024)); vhi[i]=vtr(vp_+(((i)>>2)*4096+((i)&3)*1024+512)); }while(0)
  #define KRD(G,j) do{ if(G){ kload2(kf,kp0+sl_next,j); SBAR(); } }while(0)
  #define STEP(C0,C1,P0,P1,t,GK,GV,GL) do{ SBAR(); \
    const lds_cptr vp_=vp0+sl_prev; \
    VRD(0); SBAR(); float sacc=(P0[0]+P0[1]); \
    GAPA(C0=__builtin_amdgcn_mfma_f32_32x32x16_bf16(kf[0],qr[0],negm,0,0,0), P0[2],P0[3],P0[4],P0[5],     pw0[0]=PKW(P0,0), pw0[1]=PKW(P0,2), pw0); \
    VRD(4); SBAR(); GAPA(C1=__builtin_amdgcn_mfma_f32_32x32x16_bf16(kf[1],qr[0],negm,0,0,0), P0[6],P0[7],P0[8],P0[9],     pw0[2]=PKW(P0,4), pw0[3]=PKW(P0,6), pw0); \
    VRD(1); SBAR(); GAPA(C0=__builtin_amdgcn_mfma_f32_32x32x16_bf16(kf[2],qr[1],C0,0,0,0),   P0[10],P0[11],P0[12],P0[13], pw1[0]=PKW(P0,8), pw1[1]=PKW(P0,10), pw1); \
    VRD(5); SBAR(); GAPA(C1=__builtin_amdgcn_mfma_f32_32x32x16_bf16(kf[3],qr[1],C1,0,0,0),   P0[14],P0[15],P1[0],P1[1],   pw1[2]=PKW(P0,12),pw1[3]=PKW(P0,14), pw1); \
    VRD(2); SBAR(); GAPA(C0=__builtin_amdgcn_mfma_f32_32x32x16_bf16(kf[4],qr[2],C0,0,0,0),   P1[2],P1[3],P1[4],P1[5],     pw2[0]=PKW(P1,0), pw2[1]=PKW(P1,2), pw2); \
    VRD(6); SBAR(); GAPA(C1=__builtin_amdgcn_mfma_f32_32x32x16_bf16(kf[5],qr[2],C1,0,0,0),   P1[6],P1[7],P1[8],P1[9],     pw2[2]=PKW(P1,4), pw2[3]=PKW(P1,6), pw2); \
    VRD(3); SBAR(); GAPA(C0=__builtin_amdgcn_mfma_f32_32x32x16_bf16(kf[6],qr[3],C0,0,0,0),   P1[10],P1[11],P1[12],P1[13], pw3[0]=PKW(P1,8), pw3[1]=PKW(P1,10), pw3); \
    VRD(7); SBAR(); GAPA(C1=__builtin_amdgcn_mfma_f32_32x32x16_bf16(kf[7],qr[3],C1,0,0,0),   P1[14],P1[15],0.f,0.f,       pw3[2]=PKW(P1,12),pw3[3]=PKW(P1,14), pw3); \
    l_reg+=sacc; \
    if(GK){DMA_K((t)+3,sl_cur);} if(GV){DMA_V((t)+1,sl_next);} \
    CMASK(C0,C1,t); \
    { float a=MX3(C0[0],C0[1],C1[0]),b=MX3(C0[2],C0[3],C1[1]); a=MX3(a,C1[2],C1[3]); \
      _Pragma("unroll") for(int r=4;r<16;r+=4){a=MX3(a,C0[r],C0[r+1]);b=MX3(b,C0[r+2],C0[r+3]);a=MX3(a,C1[r],C1[r+1]);b=MX3(b,C1[r+2],C1[r+3]);} \
      float rm=__builtin_fmaxf(a,b); { auto rr=__builtin_amdgcn_permlane32_swap(__float_as_uint(rm),__float_as_uint(rm),false,false); rm=__builtin_fmaxf(__uint_as_float(rr[0]),__uint_as_float(rr[1])); } \
      resc=false; \
      if(__builtin_expect(__any(rm>(float)THRL),0)){ const float dl=__builtin_fmaxf(rm,0.f); mhat+=dl; \
        _Pragma("unroll") for(int r=0;r<16;++r){C0[r]-=dl;C1[r]-=dl;} \
        _Pragma("unroll") for(int r=0;r<16;++r)negm[r]=-mhat; asm volatile("":"+v"(negm)); \
        const float f=__builtin_amdgcn_exp2f(-dl); l_reg*=f; if(hi==0)wsf[r32]=f; resc=true; } } \
    SBAR(); \
    GAPB(o[0]=__builtin_amdgcn_mfma_f32_32x32x16_bf16(PAF(0),VFR(0),o[0],0,0,0), C0,0); \
    GAPB(o[1]=__builtin_amdgcn_mfma_f32_32x32x16_bf16(PAF(0),VFR(4),o[1],0,0,0), C0,4); \
    KRD(GL,0); GAPB(o[0]=__builtin_amdgcn_mfma_f32_32x32x16_bf16(PAF(1),VFR(1),o[0],0,0,0), C0,8); \
    KRD(GL,1); GAPB(o[1]=__builtin_amdgcn_mfma_f32_32x32x16_bf16(PAF(1),VFR(5),o[1],0,0,0), C0,12); \
    KRD(GL,2); GAPB(o[0]=__builtin_amdgcn_mfma_f32_32x32x16_bf16(PAF(2),VFR(2),o[0],0,0,0), C1,0); \
    KRD(GL,3); GAPB(o[1]=__builtin_amdgcn_mfma_f32_32x32x16_bf16(PAF(2),VFR(6),o[1],0,0,0), C1,4); \
    GAPB(o[0]=__builtin_amdgcn_mfma_f32_32x32x16_bf16(PAF(3),VFR(3),o[0],0,0,0), C1,8); \
    GAPB(o[1]=__builtin_amdgcn_mfma_f32_32x32x16_bf16(PAF(3),VFR(7),o[1],0,0,0), C1,12); \
    }while(0)
  int t=1;
  #undef CMASK
  #define CMASK(P0,P1,t) do{int jb_=(t)-(NT-4); if(jb_>=0)cmask(P0,P1,jb_,qrel,hi); else if(domask){ if(!((sel>>((t)>>2))&1u)){ _Pragma("unroll") for(int r_=0;r_<16;++r_){P0[r_]=-1e30f;P1[r_]=-1e30f;} } } }while(0)
  for(;t+5<NT;t+=2){
    STEP(pB0,pB1,pA0,pA1,t,true,true,true);     WAIT_BAR(2); RESC(); ROT();
    STEP(pA0,pA1,pB0,pB1,t+1,true,true,true);   WAIT_BAR(2); RESC(); ROT();
  }
  #undef CMASK
  #define CMASK(P0,P1,t) do{int jb_=(t)-(NT-4); if(jb_>=0)cmask(P0,P1,jb_,qrel,hi); else if(domask){ if(!((sel>>((t)>>2))&1u)){ _Pragma("unroll") for(int r_=0;r_<16;++r_){P0[r_]=-1e30f;P1[r_]=-1e30f;} } } }while(0)
  #define ENDW(tt) do{ if((tt)+3<NT){WAIT_BAR(2);} else if((tt)+2<NT){WAIT_BAR(1);} else {WAIT_BAR(0);} }while(0)
  for(;t+1<NT;t+=2){
    STEP(pB0,pB1,pA0,pA1,t,(t+3<NT),(t+1<NT),(t+1<NT));       ENDW(t);   RESC(); ROT();
    STEP(pA0,pA1,pB0,pB1,t+1,(t+4<NT),(t+2<NT),(t+2<NT));     ENDW(t+1); RESC(); ROT();
  }
  STEP(pB0,pB1,pA0,pA1,NT-1,false,false,false); RESC();
  { float sacc=pB0[0]+pB0[1]; _Pragma("unroll") for(int r=2;r<16;++r)sacc+=pB0[r]; _Pragma("unroll") for(int r=0;r<16;++r)sacc+=pB1[r]; l_reg+=sacc;
    pw0=(u32x4){PKW(pB0,0),PKW(pB0,2),PKW(pB0,4),PKW(pB0,6)};pw1=(u32x4){PKW(pB0,8),PKW(pB0,10),PKW(pB0,12),PKW(pB0,14)};pw2=(u32x4){PKW(pB1,0),PKW(pB1,2),PKW(pB1,4),PKW(pB1,6)};pw3=(u32x4){PKW(pB1,8),PKW(pB1,10),PKW(pB1,12),PKW(pB1,14)};
    SBAR(); pv(o,vb0+sl_cur,PAF(0),PAF(1),PAF(2),PAF(3)); }
  #undef PKW
  #undef PAF
  #undef VFR
  #undef PIN
  #undef MX3
  #undef GAPA
  #undef GAPB
  #undef EX
  #undef VRD
  #undef KRD
  #undef STEP
  #undef ENDW
  {auto rr=__builtin_amdgcn_permlane32_swap(__float_as_uint(l_reg),__float_as_uint(l_reg),false,false);l_reg=__uint_as_float(rr[0])+__uint_as_float(rr[1]);}
  if(hi==0)wsf[32+r32]=l_reg;asm volatile("s_waitcnt lgkmcnt(0)":::"memory");
  float rli[16];
  #pragma unroll
  for(int r=0;r<16;++r)rli[r]=__builtin_amdgcn_rcpf(wsf[32+crow(r,hi)]);
  bf16*Ow=O+(rowbase+q0+wid*QBLK)*QPT+h*D;
  { bf16*stg=(bf16*)(shm+LDS_OST)+wid*2048;
    #pragma unroll
    for(int r=0;r<16;++r){const int orow=crow(r,hi);
      #pragma unroll
      for(int d0=0;d0<2;++d0)stg[orow*64+d0*32+r32]=__float2bfloat16(o[d0][r]*rli[r]);}
    asm volatile("s_waitcnt lgkmcnt(0)":::"memory");
    #pragma unroll
    for(int i=0;i<4;++i){const int row=i*8+(lane>>3),ch=lane&7; const u32x4 v=*(const u32x4*)(stg+row*64+ch*8); ATTN_STORE16(Ow+(long)row*QPT+ch*8,v);} }
  asm volatile("s_waitcnt lgkmcnt(0)\n\ts_barrier":::"memory");
  #undef DMA_K
  #undef DMA_V
  #undef CMASK
  #undef START
  #undef RESC
  #undef ROT
}
constexpr int ATTN_LDS_BYTES=LDS_BYTES;

#undef SBAR
#undef WAIT_BAR
}
namespace att {
constexpr int LP = 72;
constexpr int VP = 136;
constexpr int KT_BYTES = 128 * LP * 2;
constexpr int VT_BYTES = 64 * VP * 2;
constexpr int BUF_BYTES = KT_BYTES + VT_BYTES;
constexpr int KM_OFF = 2 * BUF_BYTES;
constexpr int UNIT_OFF = 90112;
constexpr int DONE_OFF = UNIT_OFF + 64;
constexpr int NUNITS = 3 * 1024;
__device__ __forceinline__ f32x4 mfma16(bf16x8 a, bf16x8 b, f32x4 c) { return __builtin_amdgcn_mfma_f32_16x16x32_bf16(a, b, c, 0, 0, 0); }

template <int MODE>
__device__ __forceinline__ void attn_unit(LAS unsigned char* lds, bf16_t* Qb, const bf16_t* Kb, const bf16_t* VT, const float* KP, const float* sinks, int b, int h, int qt, bool dry = false) {
    int tid_ = threadIdx.x; asm volatile("" : "+v"(tid_));
    const int tid = tid_, lane = tid & 63, wid = __builtin_amdgcn_readfirstlane(tid >> 6), l15 = lane & 15, q4 = lane >> 4;
    const int t0 = qt * 128, tw = t0 + 16 * wid, tq = tw + l15;
    const size_t rowq = (size_t)b * SEQ + tq;
    int qcol, kcol, vh;
    if (MODE == 0) { qcol = h * 64; kcol = (h >> 2) * 64; vh = h >> 2; }
    else if (MODE == 1) { qcol = 512 + h * 64; kcol = 128 + h * 64; vh = 2 + h; }
    else { qcol = 1024 + h * 64; kcol = 640 + h * 64; vh = 10 + h; }
    bf16_t* Qrow = Qb + rowq * QPITCH + qcol;
    bf16x8 qf[2];
    qf[0] = *(const bf16x8*)(Qrow + 8 * q4); qf[1] = *(const bf16x8*)(Qrow + 32 + 8 * q4);
    const bf16_t* Kg = Kb + (size_t)b * SEQ * KPITCH + kcol;
    const bf16_t* Vg = VT + (size_t)(b * NVH + vh) * 64 * SEQ;
    const int srow = tid >> 3, sch = tid & 7;
    const int Tlast = qt;
    int Tfirst = 0; if (MODE == 0) { Tfirst = qt - 1; if (Tfirst < 0) Tfirst = 0; }
    const int nT = Tlast - Tfirst + 1;
    const int srow2 = tid >> 4, sch2 = tid & 15;
    unsigned sel = 0u; const int jblk = t0 >> 8;
    if (MODE == 2) {
        LAS float* km = (LAS float*)(lds + KM_OFF);
        { const int n = tid >> 6, d = tid & 63; float v = 0.f;
          if (n < jblk) { const float* p = KP + (size_t)((b * 8 + n) * 2) * 512 + h * 64 + d; v = p[0] + p[512]; }
          km[n * 64 + d] = v; }
        __syncthreads();
        float g0 = 0.f, g1 = 0.f;
#pragma unroll
        for (int k = 0; k < 8; ++k) { const bf16x8 qv = *(const bf16x8*)(Qrow + 8 * k);
#pragma unroll
            for (int e = 0; e < 8; ++e) { const float qe = bf2f((unsigned short)qv[e]); g0 += qe * km[q4 * 64 + 8 * k + e]; g1 += qe * km[(q4 + 4) * 64 + 8 * k + e]; } }
        float g[8];
#pragma unroll
        for (int n = 0; n < 8; ++n) g[n] = __shfl((n < 4) ? g0 : g1, l15 + 16 * (n & 3));
#pragma unroll
        for (int n = 0; n < 8; ++n) { int cnt = 0;
#pragma unroll
            for (int n2 = 0; n2 < 8; ++n2) if (n2 != n) cnt += (n2 < jblk && ((g[n2] > g[n]) || (g[n2] == g[n] && n2 < n))) ? 1 : 0;
            if (n < jblk && cnt < 3) sel |= (1u << n); }
    }
    bf16x8 u00, u10, u21, u31, uall;
    if (MODE == 1) {
#pragma unroll
        for (int j = 0; j < 8; ++j) { const int kin = 16 * (j >> 2) + 4 * q4 + (j & 3);
            u00[j] = (kin >= l15) ? (short)0x3F80 : (short)0; u10[j] = (kin >= 16 + l15) ? (short)0x3F80 : (short)0;
            u21[j] = (kin >= l15) ? (short)0x3F80 : (short)0; u31[j] = (kin >= 16 + l15) ? (short)0x3F80 : (short)0; uall[j] = (short)0x3F80; }
    }
    float mrun = -1e30f, lsum = 0.f, carry = 0.f; bool sbdone = false;
    if (MODE == 0) { mrun = sinks[h] * LOG2E; lsum = (q4 == 0) ? 1.f : 0.f; }
    f32x4 o[4];
#pragma unroll
    for (int dd = 0; dd < 4; ++dd) o[dd] = (f32x4){0.f, 0.f, 0.f, 0.f};
    u32x4 kreg0, kreg1, vreg0, vreg1;
#define ATT_LOAD(ks_) do { kreg0 = *(const u32x4*)(Kg + (size_t)((ks_) + srow) * KPITCH + sch * 8); kreg1 = *(const u32x4*)(Kg + (size_t)((ks_) + 64 + srow) * KPITCH + sch * 8); \
        vreg0 = *(const u32x4*)(Vg + (size_t)srow2 * SEQ + (ks_) + sch2 * 8); vreg1 = *(const u32x4*)(Vg + (size_t)(32 + srow2) * SEQ + (ks_) + sch2 * 8); } while (0)
#define ATT_STORE(buf_) do { LAS unsigned char* b_ = lds + (buf_) * BUF_BYTES; *(LAS u32x4*)(b_ + (srow * LP + sch * 8) * 2) = kreg0; *(LAS u32x4*)(b_ + ((64 + srow) * LP + sch * 8) * 2) = kreg1; \
        *(LAS u32x4*)(b_ + KT_BYTES + (srow2 * VP + sch2 * 8) * 2) = vreg0; *(LAS u32x4*)(b_ + KT_BYTES + ((32 + srow2) * VP + sch2 * 8) * 2) = vreg1; } while (0)
    { const int T = (MODE == 1) ? Tlast : Tfirst; ATT_LOAD(128 * T); ATT_STORE(0); }
    __syncthreads();
    for (int i = 0; i < nT; ++i) {
        const int T = (MODE == 1) ? (Tlast - i) : (Tfirst + i);
        if (i + 1 < nT) { const int Tn = (MODE == 1) ? (T - 1) : (T + 1); ATT_LOAD(128 * Tn); }
#pragma unroll
        for (int hh = 0; hh < 2; ++hh) {
        const int h2 = (MODE == 1) ? (1 - hh) : hh, ks = 128 * T + 64 * h2;
        LAS unsigned char* Kl = lds + (i & 1) * BUF_BYTES + h2 * (64 * LP * 2); LAS unsigned char* Vl = lds + (i & 1) * BUF_BYTES + KT_BYTES + h2 * 128;
        bool need;
        if (MODE == 0) need = (ks <= tw + 15) && (ks + 63 > tw - 128);
        else if (MODE == 1) need = (ks < tw + 15) && !sbdone;
        else need = (ks <= tw + 15);
        if (need) {
            f32x4 st[4];
#pragma unroll
            for (int s = 0; s < 4; ++s) { st[s] = (f32x4){0.f, 0.f, 0.f, 0.f};
#pragma unroll
                for (int c = 0; c < 2; ++c) { const bf16x8 a = *(const LAS bf16x8*)(Kl + ((16 * s + l15) * LP + 32 * c + 8 * q4) * 2); st[s] = mfma16(a, qf[c], st[s]); } }
            bf16x8 pf[2];
            if (MODE != 1) {
                bool blkok = true; const bool pastblk = (MODE == 2) && ((ks >> 8) < jblk); if (MODE == 2) { const int n = ks >> 8; if (n < jblk) blkok = ((sel >> n) & 1u) != 0u; }
                float mx = -INFINITY;
#pragma unroll
                for (int s = 0; s < 4; ++s)
#pragma unroll
                    for (int r = 0; r < 4; ++r) { const int key = ks + 16 * s + 4 * q4 + r; bool ok;
                        if (MODE == 0) ok = (key <= tq) && (key > tq - 128); else ok = blkok && (pastblk || key <= tq);
                        const float v = ok ? st[s][r] : -INFINITY; st[s][r] = v; mx = fmaxf(mx, v); }
                mx = fmaxf(mx, __shfl_xor(mx, 16)); mx = fmaxf(mx, __shfl_xor(mx, 32));
                const float mnew = fmaxf(mrun, mx), alpha = fast_exp2(mrun - mnew); mrun = mnew;
                float ps = 0.f;
#pragma unroll
                for (int s = 0; s < 4; ++s)
#pragma unroll
                    for (int r = 0; r < 4; ++r) { const float p = fast_exp2(st[s][r] - mnew); st[s][r] = p; ps += p; }
                lsum = lsum * alpha + ps;
#pragma unroll
                for (int dd = 0; dd < 4; ++dd) o[dd] = o[dd] * alpha;
            } else {
                float sp[4][4]; bf16x8 bh[2], bl[2];
#pragma unroll
                for (int s = 0; s < 4; ++s)
#pragma unroll
                    for (int r = 0; r < 4; ++r) { const int key = ks + 16 * s + 4 * q4 + r; const float z = st[s][r];
                        float v = fmaxf(z, 0.f) + fast_log2(1.f + fast_exp2(-fabsf(z))); sp[s][r] = (key < tq) ? v : 0.f; }
#pragma unroll
                for (int c = 0; c < 2; ++c) { u32x4 wh, wl;
#pragma unroll
                    for (int k = 0; k < 4; ++k) { const int s = 2 * c + (k >> 1), r = 2 * (k & 1);
                        const unsigned hw = cvtpk(sp[s][r], sp[s][r + 1]);
                        const float l0 = sp[s][r] - __uint_as_float(hw << 16), l1 = sp[s][r + 1] - __uint_as_float(hw & 0xffff0000u);
                        wh[k] = hw; wl[k] = cvtpk(l0, l1); }
                    bh[c] = __builtin_bit_cast(bf16x8, wh); bl[c] = __builtin_bit_cast(bf16x8, wl); }
                f32x4 ct[4];
#pragma unroll
                for (int s = 0; s < 4; ++s) ct[s] = (f32x4){carry, carry, carry, carry};
                ct[0] = mfma16(u00, bh[0], ct[0]); ct[0] = mfma16(u00, bl[0], ct[0]); ct[0] = mfma16(uall, bh[1], ct[0]); ct[0] = mfma16(uall, bl[1], ct[0]);
                ct[1] = mfma16(u10, bh[0], ct[1]); ct[1] = mfma16(u10, bl[0], ct[1]); ct[1] = mfma16(uall, bh[1], ct[1]); ct[1] = mfma16(uall, bl[1], ct[1]);
                ct[2] = mfma16(u21, bh[1], ct[2]); ct[2] = mfma16(u21, bl[1], ct[2]);
                ct[3] = mfma16(u31, bh[1], ct[3]); ct[3] = mfma16(u31, bl[1], ct[3]);
#pragma unroll
                for (int s = 0; s < 4; ++s)
#pragma unroll
                    for (int r = 0; r < 4; ++r) { const int key = ks + 16 * s + 4 * q4 + r; const float w = fast_exp2(st[s][r] - ct[s][r]); st[s][r] = (key < tq) ? w : 0.f; }
                carry = __shfl(ct[0][0], l15);
                { float cm = carry; cm = fminf(cm, __shfl_xor(cm, 1)); cm = fminf(cm, __shfl_xor(cm, 2)); cm = fminf(cm, __shfl_xor(cm, 4)); cm = fminf(cm, __shfl_xor(cm, 8)); sbdone = cm > 48.f; }
            }
#pragma unroll
            for (int c = 0; c < 2; ++c) { u32x4 w; w.x = cvtpk(st[2 * c][0], st[2 * c][1]); w.y = cvtpk(st[2 * c][2], st[2 * c][3]); w.z = cvtpk(st[2 * c + 1][0], st[2 * c + 1][1]); w.w = cvtpk(st[2 * c + 1][2], st[2 * c + 1][3]);
                pf[c] = __builtin_bit_cast(bf16x8, w); }
#pragma unroll
            for (int dd = 0; dd < 4; ++dd)
#pragma unroll
                for (int c = 0; c < 2; ++c) {
                    const s16x4 v0 = *(const LAS s16x4*)(Vl + ((16 * dd + l15) * VP + 32 * c + 4 * q4) * 2), v1 = *(const LAS s16x4*)(Vl + ((16 * dd + l15) * VP + 32 * c + 16 + 4 * q4) * 2);
                    const bf16x8 a = {v0[0], v0[1], v0[2], v0[3], v1[0], v1[1], v1[2], v1[3]};
                    o[dd] = mfma16(a, pf[c], o[dd]); }
        }
        }
        if (i + 1 < nT) ATT_STORE((i + 1) & 1);
        if (MODE == 1) { if (lane == 0) ((LAS int*)(lds + DONE_OFF))[wid * 2 + (i & 1)] = sbdone ? 1 : 0; }
        __syncthreads();
        if (MODE == 1) { const LAS int* df = (const LAS int*)(lds + DONE_OFF) + (i & 1); int all = 1;
#pragma unroll
            for (int w = 0; w < 8; ++w) all &= df[2 * w];
            if (all) break; }
    }
    if (MODE == 1) __syncthreads();
#undef ATT_LOAD
#undef ATT_STORE
    float inv = 1.f;
    if (MODE != 1) { lsum += __shfl_xor(lsum, 16); lsum += __shfl_xor(lsum, 32); inv = 1.f / lsum; }
    if (!dry || lsum == 12345.678f)
#pragma unroll
    for (int dd = 0; dd < 4; ++dd) { const f32x4 v = o[dd] * inv; u32x2 w; w.x = cvtpk(v[0], v[1]); w.y = cvtpk(v[2], v[3]); *(u32x2*)(Qrow + 16 * dd + 4 * q4) = w; }
}

constexpr int NUNITS2 = 512 + 2048;
__device__ __forceinline__ void attn_phase(LAS unsigned char* lds, unsigned char* lds_generic, bf16_t* Qb, const bf16_t* Kb, const bf16_t* VT, const bf16_t* VC, const float* KP, const float* sinks, unsigned* ctr, bool dry = false) {
    LAS int* uw = (LAS int*)(lds + UNIT_OFF);
    for (;;) {
        if (threadIdx.x == 0) uw[0] = (int)atomicAdd(ctr, 1u);
        __syncthreads();
        const int idx = uw[0];
        __syncthreads();
        if (idx >= 512) break;
        const int qb = 7 - (idx >> 6), bh = idx & 63;
        attn_body::attn_unit<8>(bh >> 3, bh & 7, qb, (const attn_body::bf16*)(Qb + 1024), (const attn_body::bf16*)(Kb + 640), (const attn_body::bf16*)VC, (attn_body::bf16*)(Qb + 1024), (char*)lds_generic, KP);
    }
    for (;;) {
        if (threadIdx.x == 0) uw[0] = (int)atomicAdd(ctr + 16, 1u);
        __syncthreads();
        const int idx = uw[0];
        __syncthreads();
        if (idx >= 2048) break;
        if (idx < 1024) { const int qt = 15 - (idx >> 6), bh = idx & 63; attn_unit<1>(lds, Qb, Kb, VT, KP, sinks, bh >> 3, bh & 7, qt, dry); }
        else { const int ii = idx - 1024, qt = ii >> 6, bh = ii & 63; attn_unit<0>(lds, Qb, Kb, VT, KP, sinks, bh >> 3, bh & 7, qt, dry); }
    }
}
}
__device__ __forceinline__ float wave_sum(float v) {
#pragma unroll
    for (int o = 1; o < 64; o <<= 1) v += __shfl_xor(v, o);
    return v;
}
template <bool OUT_F32> __device__ __forceinline__ void rms_row(const float* xrow, const float* g, void* orow, int lane, bf16_t* hrow = nullptr) {
    const f32x4* xr = (const f32x4*)xrow + lane; const f32x4* gr = (const f32x4*)g + lane;
    f32x4 v[4]; float s = 0.f;
#pragma unroll
    for (int j = 0; j < 4; ++j) { v[j] = xr[64 * j]; s += (v[j].x * v[j].x + v[j].y * v[j].y) + (v[j].z * v[j].z + v[j].w * v[j].w); }
    const float rs = 1.0f / sqrtf(wave_sum(s) * (1.f / DM) + RMS_EPS);
#pragma unroll
    for (int j = 0; j < 4; ++j) { const f32x4 y = v[j] * rs * gr[64 * j];
        if (OUT_F32) ((f32x4*)orow)[lane + 64 * j] = y;
        else { u32x2 w; w.x = cvtpk(y.x, y.y); w.y = cvtpk(y.z, y.w); ((u32x2*)orow)[lane + 64 * j] = w; if (hrow) ((u32x2*)hrow)[lane + 64 * j] = w; } }
}
template <bool OUT_F32> __device__ __forceinline__ void rms_phase(const float* x, const float* g, void* out, int gw, int NGW, int lane, bf16_t* AH = nullptr) {
    asm volatile("" : "+v"(lane));
    for (int m = gw; m < TOK; m += NGW) { bf16_t* hrow = nullptr; if (AH && (m & 255) >= 254 && (m >> 8) < 63) hrow = AH + (size_t)(2 * ((m >> 8) + 1) + (m & 255) - 254) * DM;
        rms_row<OUT_F32>(x + (size_t)m * DM, g, OUT_F32 ? (void*)((float*)out + (size_t)m * DM) : (void*)((bf16_t*)out + (size_t)m * DM), lane, hrow); }
}
__device__ __forceinline__ int ropeperm(int c) { const int cp = c & 63; return (c & ~63) + 16 * (cp >> 5) + (cp & 15) + 32 * ((cp >> 4) & 1); }
template <int MAP> __device__ __forceinline__ int map_col(int n) {
    if (MAP == 0) return n;
    if (MAP == 1) {
        if (n < 512) return ropeperm(n);
        if (n < 1024) return 768 + (n - 512);
        if (n < 1536) return 2304 + ropeperm(n - 1024);
        if (n < 1664) return 512 + ropeperm(n - 1536);
        if (n < 1792) return 640 + (n - 1664);
        if (n < 2304) return 1280 + (n - 1792);
        if (n < 2816) return 1792 + (n - 2304);
        if (n < 3328) return 2816 + ropeperm(n - 2816);
        return 3328 + (n - 3328);
    }
    { const int pn = n >> 8, half = (n >> 7) & 1, c = 128 * pn + (n & 127); return half ? DFF + c : c; }
}
template <int MAP> __device__ __forceinline__ void transpose_job(const float* W, int ldw, int coloff, int K, int NP, bf16_t* WT, LAS float* scr, int& base, int gw, int NGW, int lane) {
    const int nblk = NP / 32, items = (K / 64) * nblk;
    int start = (gw - base) % NGW; if (start < 0) start += NGW;
    for (int it = start; it < items; it += NGW) {
        const int kb = it / nblk, nb = it % nblk, k0 = 64 * kb, n0 = 32 * nb;
        const int sc = coloff + map_col<MAP>(n0 + (lane & 31));
#pragma unroll 8
        for (int i = 0; i < 32; ++i) { const int kk = 2 * i + (lane >> 5); scr[kk * 33 + (lane & 31)] = W[(size_t)(k0 + kk) * ldw + sc]; }
        asm volatile("s_waitcnt lgkmcnt(0)" ::: "memory");
        const int c = lane & 7;
#pragma unroll
        for (int j = 0; j < 4; ++j) { const int n = (lane >> 3) + 8 * j; const LAS float* s = scr + (8 * c) * 33 + n;
            u32x4 o; o.x = cvtpk(s[0 * 33], s[1 * 33]); o.y = cvtpk(s[2 * 33], s[3 * 33]); o.z = cvtpk(s[4 * 33], s[5 * 33]); o.w = cvtpk(s[6 * 33], s[7 * 33]);
            *(u32x4*)(WT + (size_t)(n0 + n) * K + k0 + 8 * c) = o; }
        asm volatile("s_waitcnt lgkmcnt(0)" ::: "memory");
    }
    base = (base + items) % NGW;
}

__device__ __forceinline__ void xg_phase(const float* x, const float* g, bf16_t* XG, float* rss, int gw, int NGW, int lane) {
    asm volatile("" : "+v"(lane));
    for (int m = gw; m < TOK; m += NGW) {
        const f32x4* xr = (const f32x4*)(x + (size_t)m * DM) + lane; const f32x4* gr = (const f32x4*)g + lane; float s = 0.f;
#pragma unroll
        for (int j = 0; j < 4; ++j) { const f32x4 v = xr[64 * j]; s += (v.x * v.x + v.y * v.y) + (v.z * v.z + v.w * v.w); const f32x4 y = v * gr[64 * j];
            u32x2 w; w.x = cvtpk(y.x, y.y); w.y = cvtpk(y.z, y.w); ((u32x2*)(XG + (size_t)m * DM))[lane + 64 * j] = w; }
        s = wave_sum(s); if (lane == 0) rss[m] = s;
    }
}
__device__ __forceinline__ void final_phase(float* x, const float* g, const float* rss, int gw, int NGW, int lane) {
    asm volatile("" : "+v"(lane));
    for (int m = gw; m < TOK; m += NGW) { const float rsv = rs_of(rss[m]); f32x4* xr = (f32x4*)(x + (size_t)m * DM) + lane; const f32x4* gr = (const f32x4*)g + lane;
#pragma unroll
        for (int j = 0; j < 4; ++j) xr[64 * j] = xr[64 * j] * rsv * gr[64 * j]; }
}
constexpr int LDS_BYTES = 147456;
constexpr int NPH = 18;
#ifndef PHMASK
#define PHMASK 0xFFFF
#endif
#define KEN(n) (((PHMASK) >> (n)) & 1)
struct Args { const float* in[13]; float* out; unsigned char* ws; int ph_lo, ph_hi; };
static_assert(sizeof(Args) == 13 * 8 + 8 + 8 + 8, "Args has no padding");

__global__ void __launch_bounds__(NTHREADS, 2) fwd_kernel(Args a) {
    extern __shared__ __attribute__((aligned(16))) unsigned char lds_raw[];
    LAS unsigned char* lds = (LAS unsigned char*)lds_raw;
    const int tid = threadIdx.x, wave = __builtin_amdgcn_readfirstlane(tid >> 6);
#define LANE_OPAQUE() ({ int t_ = threadIdx.x; asm volatile("" : "+v"(t_)); t_ & 63; })
    const int G = gridDim.x, bx = blockIdx.x;
    const int gw = bx * NWAVES + wave, NGW = G * NWAVES, NGT = G * NTHREADS;
    unsigned char* ws = a.ws;
    const float* x_in = a.in[0]; float* xo = a.out;
    bf16_t* Hb = (bf16_t*)(ws + WS_H); bf16_t* Qb = (bf16_t*)(ws + WS_Q); bf16_t* Gb = (bf16_t*)(ws + WS_G); bf16_t* Kb = (bf16_t*)(ws + WS_K); bf16_t* VTb = (bf16_t*)(ws + WS_VT);
    float* ropeC = (float*)(ws + WS_ROPE); float* ropeS = ropeC + SEQ * 32; float* KPb = (float*)(ws + WS_KP);
    unsigned* ctl = (unsigned*)(ws + WS_CTL); float* RS = (float*)(ws + WS_RS);
    const int lo = a.ph_lo, hi = a.ph_hi;
#define RUN(k) (lo <= (k) && (k) < hi)
#if MK_ONE_LAUNCH
    volatile LAS unsigned* MISC = (volatile LAS unsigned*)(lds + 131072 + 320);
    if (tid < 32) MISC[tid] = 0u;
    __syncthreads();
    XcdBarrier bar = xcd_barrier_post(ctl + 4096, MISC + 8);
#define SEAM(k) do { if (RUN(k) && RUN((k) + 1)) { if ((k) == 0) cg::this_grid().sync(); else xcd_barrier(bar); } } while (0)
#else
#define SEAM(k) do { } while (0)
#endif

#ifdef DBL_P0
    for (int rep_ = 0; rep_ < 2; ++rep_)
#endif
    if (KEN(0) && RUN(0)) {
        LAS float* scr = (LAS float*)(lds + wave * 16384);
        int base = 0; const int lane = LANE_OPAQUE(); const int gtid = bx * NTHREADS + wave * 64 + lane;
        for (int l = 0; l < 2; ++l) {
            unsigned char* wb = ws + WS_WB + (size_t)l * WB_LAYER;
            const float* w_in = a.in[2] + (size_t)l * DM * D_IN;
            transpose_job<1>(w_in, D_IN, 0, DM, NQKV, (bf16_t*)(wb + WB_IN), scr, base, gw, NGW, lane);
            transpose_job<0>(w_in, D_IN, NQKV, DM, NGATE, (bf16_t*)(wb + WB_G), scr, base, gw, NGW, lane);
            for (int i = 0; i < 3; ++i) transpose_job<0>(a.in[5] + (size_t)(l * 3 + i) * 512 * DM, DM, 0, 512, DM, (bf16_t*)(wb + WB_BR + (size_t)i * DM * 512 * 2), scr, base, gw, NGW, lane);
            transpose_job<0>(a.in[6] + (size_t)l * DM * DM, DM, 0, DM, DM, (bf16_t*)(wb + WB_O), scr, base, gw, NGW, lane);
            transpose_job<2>(a.in[8] + (size_t)l * DM * 2 * DFF, 2 * DFF, 0, DM, 2 * DFF, (bf16_t*)(wb + WB_U), scr, base, gw, NGW, lane);
            transpose_job<0>(a.in[11] + (size_t)l * DFF * DM, DM, 0, DFF, DM, (bf16_t*)(wb + WB_D), scr, base, gw, NGW, lane);
        }
        for (int i = gtid; i < SEQ * 32; i += NGT) {
            const int t = i >> 5, f = i & 31;
            const float inv = exp2f(-(float)f * (13.287712379549449f / 32.0f));
            const float ang = (float)t * inv;
            const double rev = (double)ang * 0.15915494309189535; const float fr = (float)(rev - rint(rev));
            ropeC[i] = __builtin_amdgcn_cosf(fr); ropeS[i] = __builtin_amdgcn_sinf(fr);
        }
        xg_phase(x_in, a.in[1], Hb, RS, gw, NGW, lane);
        __syncthreads();
    }
    SEAM(0);
    for (int l = 0; l < 2; ++l) {
        const int pb = 1 + 8 * l;
        unsigned char* wb = ws + WS_WB + (size_t)l * WB_LAYER;
#ifdef DBL_PA
        for (int rep_ = 0; rep_ < 2; ++rep_)
#endif
        if (KEN(1) && RUN(pb + 0)) {
            pg8::Gemm g{Hb, (const bf16_t*)(wb + WB_IN), TOK, NQKV, DM, DM, 0, 0}; pg8::StaticOrder S; S.init(TOK, NQKV, G, bx);
            pg8::EpiInproj E{Qb, Kb, VTb, KPb, ropeC, ropeS, RS + (size_t)(2 * l) * TOK, (bf16_t*)(ws + WS_VC)};
            pg8::gemm_phase<pg8::EpiInproj, pg8::StaticOrder, true, true>(lds, g, S, E);
        }
        SEAM(pb + 0);
        if (KEN(2) && RUN(pb + 1)) { att::attn_phase(lds, lds_raw, Qb, Kb, VTb, (const bf16_t*)(ws + WS_VC), KPb, a.in[4] + l * 8, ctl + 64 * l); }
        SEAM(pb + 1);
#ifdef DBL_PC
        for (int rep_ = 0; rep_ < 2; ++rep_)
#endif
        if (KEN(3) && RUN(pb + 2)) {
            pg8::Gemm g{Hb, (const bf16_t*)(wb + WB_G), TOK, NGATE, DM, DM, 0, 0}; pg8::StaticOrder S; S.init(TOK, NGATE, G, bx);
            pg8::EpiRowBf16<2> E{Gb, NGATE, a.in[3] + (size_t)l * NGATE, RS + (size_t)(2 * l) * TOK};
            pg8::gemm_phase<pg8::EpiRowBf16<2>, pg8::StaticOrder, true, true>(lds, g, S, E);
        }
        SEAM(pb + 2);
#ifdef DBL_PD
        for (int rep_ = 0; rep_ < 2; ++rep_)
#endif
        if (KEN(4) && RUN(pb + 3)) {
            pg8::Gemm g{Qb, (const bf16_t*)(wb + WB_BR), TOK, DM, 512, QPITCH, (size_t)512 * 2, (size_t)DM * 512 * 2}; pg8::StaticOrder3 S; S.init(TOK, DM, G, bx);
            pg8::EpiBranch E{Hb, Gb};
            pg8::gemm_phase<pg8::EpiBranch, pg8::StaticOrder3, true, true>(lds, g, S, E);
        }
        SEAM(pb + 3);
        if (KEN(5) && RUN(pb + 4)) {
            pg8::Gemm g{Hb, (const bf16_t*)(wb + WB_O), TOK, DM, DM, DM, 0, 0}; pg8::StaticOrder S; S.init(TOK, DM, G, bx);
            pg8::EpiResidualNorm E{l == 0 ? x_in : (const float*)xo, xo, Qb, a.in[7] + (size_t)l * DM, RS + (size_t)(2 * l + 1) * TOK, (bf16_t*)(ws + WS_AH)};
            pg8::gemm_phase<pg8::EpiResidualNorm, pg8::StaticOrder, true, true>(lds, g, S, E);
        }
        SEAM(pb + 4);
#ifdef DBL_PH
        for (int rep_ = 0; rep_ < 2; ++rep_)
#endif
        if (KEN(7) && RUN(pb + 5)) {
            pg8::Gemm g{(const bf16_t*)(ws + WS_AH), (const bf16_t*)(wb + WB_U), 256, 2 * DFF, DM, DM, 0, 0}; pg8::StaticOrder S; S.init(256, 2 * DFF, G, bx);
            pg8::EpiHalo E{(float*)(ws + WS_UH), RS + (size_t)(2 * l + 1) * TOK};
            pg8::gemm_phase<pg8::EpiHalo, pg8::StaticOrder, true, true>(lds, g, S, E);
        }
        SEAM(pb + 5);
#ifdef DBL_PG
        for (int rep_ = 0; rep_ < 2; ++rep_)
#endif
        if (KEN(8) && RUN(pb + 6)) {
            pg8::Gemm g{Qb, (const bf16_t*)(wb + WB_U), TOK, 2 * DFF, DM, DM, 0, 0}; pg8::StaticOrder S; S.init(TOK, 2 * DFF, G, bx);
            pg8::EpiUpConv E{Gb, (const float*)(ws + WS_UH), a.in[9] + (size_t)l * 3 * 2 * DFF, a.in[10] + (size_t)l * 2 * DFF, (LAS float*)(lds + 131072 + 1024), RS + (size_t)(2 * l + 1) * TOK};
            pg8::gemm_phase<pg8::EpiUpConv, pg8::StaticOrder, true, true>(lds, g, S, E);
        }
        SEAM(pb + 6);
        if (KEN(9) && RUN(pb + 7)) {
            pg8::Gemm g{Gb, (const bf16_t*)(wb + WB_D), TOK, DM, DFF, DFF, 0, 0}; pg8::StaticOrder S; S.init(TOK, DM, G, bx);
            pg8::EpiResidualNorm E{xo, xo, l == 0 ? Hb : (bf16_t*)nullptr, l == 0 ? a.in[1] + DM : (const float*)nullptr, RS + (size_t)(l == 0 ? 2 : 4) * TOK, (bf16_t*)nullptr};
            pg8::gemm_phase<pg8::EpiResidualNorm, pg8::StaticOrder, true, true>(lds, g, S, E);
        }
        SEAM(pb + 7);
    }
    if (KEN(10) && RUN(17)) { final_phase(xo, a.in[12], RS + (size_t)4 * TOK, gw, NGW, LANE_OPAQUE()); }
#undef RUN
#undef SEAM
}

extern "C" void kernel_launch(void* const* d_in, const int* in_sizes, int n_in, void* d_out, int out_size, void* d_ws, size_t ws_size, hipStream_t stream) {
    static int grid = 0;
    if (grid == 0) {
        if (n_in != 13 || in_sizes[0] != TOK * DM || out_size != TOK * DM || ws_size < WS_END) { fprintf(stderr, "kernel_launch: unexpected shapes / workspace (n_in %d, ws %zu)\n", n_in, ws_size); grid = -1; return; }
        int dev = 0, cus = 0, per_cu = 0;
        hipGetDevice(&dev); hipDeviceGetAttribute(&cus, hipDeviceAttributeMultiprocessorCount, dev);
        if (hipFuncSetAttribute((const void*)fwd_kernel, hipFuncAttributeMaxDynamicSharedMemorySize, LDS_BYTES) != hipSuccess) { fprintf(stderr, "kernel_launch: hipFuncSetAttribute failed\n"); grid = -1; return; }
        if (hipOccupancyMaxActiveBlocksPerMultiprocessor(&per_cu, (const void*)fwd_kernel, NTHREADS, LDS_BYTES) != hipSuccess || per_cu < 1) { fprintf(stderr, "kernel_launch: occupancy query gave %d\n", per_cu); per_cu = 1; }
        (void)hipGetLastError();
        grid = cus * per_cu;
    }
    if (grid < 0) return;
    hipMemsetAsync((char*)d_ws + WS_CTL, 0, CTL_BYTES + RS_BYTES, stream);
    Args a{};
    for (int i = 0; i < 13; ++i) a.in[i] = (const float*)d_in[i];
    a.out = (float*)d_out; a.ws = (unsigned char*)d_ws;
#if MK_ONE_LAUNCH
    a.ph_lo = 0; a.ph_hi = NPH;
    void* args[] = {&a};
    hipError_t e = hipLaunchCooperativeKernel((const void*)fwd_kernel, dim3(grid), dim3(NTHREADS), args, LDS_BYTES, stream);
    if (e != hipSuccess) fprintf(stderr, "cooperative launch failed: %s (grid %d)\n", hipGetErrorString(e), grid);
#else
    for (int p = 0; p < NPH; ++p) { a.ph_lo = p; a.ph_hi = p + 1; hipLaunchKernelGGL(fwd_kernel, dim3(grid), dim3(NTHREADS), LDS_BYTES, stream, a); }
#endif
}
```
